# Optimizing an MI355X kernel written in HIP

```python
import jax, jax.numpy as jnp
from jax import lax
import numpy as np

D_MODEL = 2048
BATCH = 16
SEQ = 2048
DEPTH = 2

CHUNK = 64
Q_BLOCK = 128
EPS = 1e-6
PLE_DIM = 256

A_HEADS = 8
A_LATENT = 128
A_TOPK_MAX = 256
IDX_HEADS = 16
IDX_DIM = 64
B_HEADS = 4
B_DK = 128
B_DV = 256
B_GATE_RANK = 16
B_GATE_NORM = 16.0
C_HEADS = 16
C_HEAD_DIM = D_MODEL // C_HEADS
C_WIDTH = C_HEADS * C_HEAD_DIM
FFN_HIDDEN = -(-8 * D_MODEL // (3 * 256)) * 256

EVEN_WIDTHS = (A_HEADS * A_LATENT, A_LATENT, IDX_HEADS * IDX_DIM, IDX_DIM, IDX_HEADS,
               B_HEADS * B_DK, B_HEADS * B_DK, B_HEADS * B_DV, B_HEADS * B_DV, B_GATE_RANK)
EVEN_IN = sum(EVEN_WIDTHS)
EVEN_SPLITS = [sum(EVEN_WIDTHS[:i + 1]) for i in range(len(EVEN_WIDTHS) - 1)]
EVEN_OUT = A_HEADS * A_LATENT + B_HEADS * B_DV

kernel_name = 'hybrid_dsa_gla_stickbreaking'


def _rmsnorm(x, g):
    xf = x.astype(jnp.float32)
    y = xf * lax.rsqrt(jnp.mean(xf * xf, axis=-1, keepdims=True) + EPS)
    return (y * g.astype(jnp.float32)).astype(x.dtype)


def _dsa(q_a, c, q_i, k_i, w_i):
    b, s_len = q_a.shape[0], q_a.shape[1]
    topk = min(A_TOPK_MAX, s_len // 4)
    nb = s_len // Q_BLOCK
    key_pos = jnp.arange(s_len, dtype=jnp.int32)
    starts = jnp.arange(nb, dtype=jnp.int32) * Q_BLOCK

    def to_blocks(t):
        return jnp.moveaxis(t.reshape((b, nb, Q_BLOCK) + t.shape[2:]), 1, 0)

    def one_block(args):
        qa, qi, wi, start = args
        limit = ((start + jnp.arange(Q_BLOCK, dtype=jnp.int32)) // CHUNK + 1) * CHUNK
        admissible = key_pos[None, :] < limit[:, None]
        logits = jnp.einsum('bqhd,bsd->bqsh', qi, k_i).astype(jnp.float32) * IDX_DIM ** -0.5
        score = jnp.einsum('bqsh,bqh->bqs', jax.nn.relu(logits),
                           wi.astype(jnp.float32)) * IDX_HEADS ** -0.5
        score = jnp.where(admissible[None], score, -jnp.inf)
        _, idx = lax.top_k(score, topk)
        c_sel = jax.vmap(lambda cb, ib: cb[ib])(c, idx)
        valid = idx < limit[None, :, None]
        att = jnp.einsum('bqhd,bqkd->bqhk', qa, c_sel).astype(jnp.float32) * A_LATENT ** -0.5
        att = jnp.where(valid[:, :, None, :], att, -jnp.inf)
        prob = jax.nn.softmax(att, axis=-1).astype(c.dtype)
        return jnp.einsum('bqhk,bqkd->bqhd', prob, c_sel)

    out = lax.map(one_block, (to_blocks(q_a), to_blocks(q_i), to_blocks(w_i), starts))
    return jnp.moveaxis(out, 0, 1).reshape(b, s_len, A_HEADS * A_LATENT)


def _gla(q, k, v, gk):
    b, s_len, h, dk = q.shape
    dv = v.shape[-1]
    nc = s_len // CHUNK

    def to_chunks(t):
        return t.reshape(b, nc, CHUNK, h, t.shape[-1]).transpose(0, 3, 1, 2, 4)

    f32 = jnp.float32
    q = to_chunks(q).astype(f32) * dk ** -0.5
    k = to_chunks(k).astype(f32)
    v = to_chunks(v).astype(f32)
    G = jnp.cumsum(to_chunks(gk.astype(f32)), axis=3)
    G_last = G[:, :, :, -1:, :]
    q_e = q * jnp.exp(G)
    k_e = k * jnp.exp(-G)
    k_d = k * jnp.exp(G_last - G)
    causal = jnp.tril(jnp.ones((CHUNK, CHUNK), dtype=bool))
    att = jnp.where(causal, jnp.einsum('bhncd,bhnsd->bhncs', q_e, k_e), 0.0)
    o = jnp.einsum('bhncs,bhnsv->bhncv', att, v)
    kv = jnp.einsum('bhnsd,bhnsv->bhndv', k_d, v)
    decay = jnp.exp(G_last[:, :, :, 0, :])

    def step(state, inp):
        dec, inc = inp
        return dec[..., None] * state + inc, state

    s0 = jnp.zeros((b, h, dk, dv), f32)
    _, s_prev = lax.scan(step, s0, (jnp.moveaxis(decay, 2, 0), jnp.moveaxis(kv, 2, 0)))
    s_prev = jnp.moveaxis(s_prev, 0, 2)
    o = o + jnp.einsum('bhncd,bhndv->bhncv', q_e, s_prev)
    return o.transpose(0, 2, 3, 1, 4).reshape(b, s_len, h, dv)


def _stick_breaking(q, k, v):
    b, s_len, h, d = q.shape
    q, k, v = (t.transpose(0, 2, 1, 3) for t in (q, k, v))
    outs = []
    for n in range(s_len // Q_BLOCK):
        start, end = n * Q_BLOCK, (n + 1) * Q_BLOCK
        z = jnp.einsum('bhqd,bhsd->bhqs', q[:, :, start:end], k[:, :, :end]).astype(jnp.float32) * d ** -0.5
        qpos = start + jnp.arange(Q_BLOCK)
        kpos = jnp.arange(end)
        mask = kpos[None, :] < qpos[:, None]
        log_1mb = jnp.where(mask, -jax.nn.softplus(z), 0.0)
        suffix = lax.cumsum(log_1mb, axis=3, reverse=True) - log_1mb
        weight = jnp.where(mask, jnp.exp(suffix - jax.nn.softplus(-z)), 0.0)
        outs.append(jnp.einsum('bhqs,bhsd->bhqd', weight.astype(v.dtype), v[:, :, :end]))
    o = jnp.concatenate(outs, axis=2)
    return o.transpose(0, 2, 1, 3).reshape(b, s_len, h * d)


def _even_mixer(h, norm_g, w_in, w_gk, b_gk, gla_norm, w_out):
    b, s_len, _ = h.shape
    u = _rmsnorm(h, norm_g) @ w_in
    q_a, c_a, q_i, k_i, w_i, q_b, k_b, v_b, g_b, gk_lr = jnp.split(u, EVEN_SPLITS, axis=-1)
    o_a = _dsa(q_a.reshape(b, s_len, A_HEADS, A_LATENT), c_a,
               q_i.reshape(b, s_len, IDX_HEADS, IDX_DIM), k_i, w_i)
    gk = jax.nn.log_sigmoid((gk_lr @ w_gk + b_gk).astype(jnp.float32)) / B_GATE_NORM
    o_b = _gla(q_b.reshape(b, s_len, B_HEADS, B_DK), k_b.reshape(b, s_len, B_HEADS, B_DK),
               v_b.reshape(b, s_len, B_HEADS, B_DV), gk.reshape(b, s_len, B_HEADS, B_DK))
    o_b = _rmsnorm(o_b, gla_norm) * jax.nn.silu(g_b.reshape(b, s_len, B_HEADS, B_DV).astype(jnp.float32))
    o = jnp.concatenate([o_a.astype(h.dtype), o_b.reshape(b, s_len, B_HEADS * B_DV).astype(h.dtype)], axis=-1)
    return o @ w_out


def _odd_mixer(h, norm_g, w_in, w_out):
    b, s_len, _ = h.shape
    q, k, v = jnp.split(_rmsnorm(h, norm_g) @ w_in, 3, axis=-1)
    shp = (b, s_len, C_HEADS, C_HEAD_DIM)
    o = _stick_breaking(q.reshape(shp), k.reshape(shp), v.reshape(shp))
    return o.astype(h.dtype) @ w_out


def _swiglu(h, norm_g, w_gate, w_up, w_down):
    xn = _rmsnorm(h, norm_g)
    return (jax.nn.silu(xn @ w_gate) * (xn @ w_up)) @ w_down


def setup_inputs(seed: int = 0) -> dict:
    key = jax.random.key(seed)
    ks = jax.random.split(key, 20)
    f32 = jnp.float32
    ne = (DEPTH + 1) // 2
    no = DEPTH // 2

    def dense(k, shape):
        return jax.random.normal(k, shape, f32) * shape[-2] ** -0.5

    def gain(k, shape):
        return 1.0 + 0.02 * jax.random.normal(k, shape, f32)

    return {
        'x': jax.random.normal(ks[0], (BATCH, SEQ, D_MODEL), f32),
        'p': jax.random.normal(ks[1], (DEPTH, BATCH, SEQ, PLE_DIM), f32),
        'even_norm': gain(ks[2], (ne, D_MODEL)),
        'even_w_in': dense(ks[3], (ne, D_MODEL, EVEN_IN)),
        'even_w_gk': dense(ks[4], (ne, B_GATE_RANK, B_HEADS * B_DK)),
        'even_b_gk': 0.01 * jax.random.normal(ks[5], (ne, B_HEADS * B_DK), f32),
        'even_gla_norm': gain(ks[6], (ne, B_DV)),
        'even_w_out': dense(ks[7], (ne, EVEN_OUT, D_MODEL)),
        'odd_norm': gain(ks[8], (no, D_MODEL)),
        'odd_w_in': dense(ks[9], (no, D_MODEL, 3 * C_WIDTH)),
        'odd_w_out': dense(ks[10], (no, C_WIDTH, D_MODEL)),
        'ffn_norm': gain(ks[11], (DEPTH, D_MODEL)),
        'ffn_w_gate': dense(ks[12], (DEPTH, D_MODEL, FFN_HIDDEN)),
        'ffn_w_up': dense(ks[13], (DEPTH, D_MODEL, FFN_HIDDEN)),
        'ffn_w_down': dense(ks[14], (DEPTH, FFN_HIDDEN, D_MODEL)),
        'ple_norm': gain(ks[15], (DEPTH, D_MODEL)),
        'ple_w_gate': dense(ks[16], (DEPTH, D_MODEL, D_MODEL)),
        'ple_w_proj': dense(ks[17], (DEPTH, PLE_DIM, D_MODEL)),
        'final_norm': gain(ks[18], (D_MODEL,)),
    }


def reference(x, p, even_norm, even_w_in, even_w_gk, even_b_gk, even_gla_norm, even_w_out,
              odd_norm, odd_w_in, odd_w_out, ffn_norm, ffn_w_gate, ffn_w_up, ffn_w_down,
              ple_norm, ple_w_gate, ple_w_proj, final_norm):
    h = x
    for i in range(DEPTH):
        j = i // 2
        if i % 2 == 0:
            h = h + _even_mixer(h, even_norm[j], even_w_in[j], even_w_gk[j], even_b_gk[j],
                                even_gla_norm[j], even_w_out[j])
        else:
            h = h + _odd_mixer(h, odd_norm[j], odd_w_in[j], odd_w_out[j])
        h = h + _swiglu(h, ffn_norm[i], ffn_w_gate[i], ffn_w_up[i], ffn_w_down[i])
        gate = jax.nn.sigmoid(_rmsnorm(h, ple_norm[i]) @ ple_w_gate[i])
        h = h + (p[i] @ ple_w_proj[i]) * gate
    return _rmsnorm(h, final_norm)
```

```cpp
#include <hip/hip_runtime.h>
#include <cstdio>
#include <cstdint>

constexpr int NB = 16, SEQ = 2048, DM = 2048, MT = NB * SEQ;
constexpr int PLE = 256, FF = 5632;
constexpr int EVEN_IN = 5344, LDU = 5376;
constexpr int U_QA = 0, U_CA = 1024, U_QI = 1152, U_KI = 2176, U_WI = 2240, U_QB = 2256, U_KB = 2768, U_VB = 3280, U_GB = 4304, U_LR = 5328;
constexpr int LDQKV = 6144;
constexpr float EPS = 1e-6f;
constexpr int NWAVES = 8;

constexpr size_t MiB = 1u << 20;
constexpr size_t WS_CTL = 0, CTL_ZERO_BYTES = 1 * MiB;
constexpr size_t WS_WIN0 = 1 * MiB;
constexpr size_t WS_WOUT0 = WS_WIN0 + 21 * MiB;
constexpr size_t WS_WIN1 = WS_WOUT0 + 8 * MiB;
constexpr size_t WS_WOUT1 = WS_WIN1 + 24 * MiB;
constexpr size_t WS_WGU = WS_WOUT1 + 8 * MiB;
constexpr size_t WS_WD = WS_WGU + 88 * MiB;
constexpr size_t WS_WPG = WS_WD + 44 * MiB;
constexpr size_t WS_WPE = WS_WPG + 16 * MiB;
constexpr size_t WS_RSTD = WS_WPE + 2 * MiB;
constexpr size_t WS_HB = WS_RSTD + 1 * MiB;
constexpr size_t WS_PB = WS_HB + 128 * MiB;
constexpr size_t WS_BIG = WS_PB + 32 * MiB;
constexpr size_t WS_OB = WS_BIG + 384 * MiB;
constexpr size_t WS_MASK = WS_OB + 128 * MiB;
constexpr size_t WS_ORAW = WS_MASK + 8 * MiB;
constexpr size_t WS_END = WS_ORAW + 128 * MiB;
static_assert(WS_END <= 1024 * MiB, "workspace map must fit 4 x 256 MiB");

constexpr int CW_TMO = 0, CW_CODE = 1, CW_BAR = 4096, CW_Q = 8192;

constexpr int RING_OFF = 0, RING_BYTES = 131072;
constexpr int LDSCTL_OFF = RING_BYTES, MISC_OFF = LDSCTL_OFF + 320;
constexpr int LDS_BYTES = 147456;

#define GAS __attribute__((address_space(1)))
#define LAS __attribute__((address_space(3)))
typedef unsigned short bf16;
typedef unsigned v4u __attribute__((ext_vector_type(4)));
typedef unsigned v2u __attribute__((ext_vector_type(2)));
typedef float f32x4 __attribute__((ext_vector_type(4)));
typedef float f32x2 __attribute__((ext_vector_type(2)));
typedef float f32x16 __attribute__((ext_vector_type(16)));
typedef short bf16x8 __attribute__((ext_vector_type(8)));
typedef short s16x4 __attribute__((ext_vector_type(4)));
typedef GAS unsigned gu32;
#define RLX_AGENT __ATOMIC_RELAXED, __HIP_MEMORY_SCOPE_AGENT
#define LDS_WAIT() asm volatile("s_waitcnt lgkmcnt(0)" ::: "memory")
#define VM_WAIT() asm volatile("s_waitcnt vmcnt(0)" ::: "memory")
__device__ __forceinline__ unsigned f2bf(float f) { unsigned u = __builtin_bit_cast(unsigned, f); return (u + 0x7fffu + ((u >> 16) & 1u)) >> 16; }
__device__ __forceinline__ unsigned pk2(float lo, float hi) { return f2bf(lo) | (f2bf(hi) << 16); }
__device__ __forceinline__ float bf2f(unsigned short b) { return __builtin_bit_cast(float, ((unsigned)b) << 16); }
__device__ __forceinline__ float bflo(unsigned w) { return __builtin_bit_cast(float, w << 16); }
__device__ __forceinline__ float bfhi(unsigned w) { return __builtin_bit_cast(float, w & 0xffff0000u); }
__device__ __forceinline__ float u2f(unsigned u) { return __builtin_bit_cast(float, u); }
__device__ __forceinline__ unsigned f2u(float f) { return __builtin_bit_cast(unsigned, f); }
namespace pg8 {
#define PG8_LAS __attribute__((address_space(3)))
typedef unsigned short bf16_t;
typedef short bf16x8 __attribute__((ext_vector_type(8)));
typedef float f32x4 __attribute__((ext_vector_type(4)));
typedef unsigned u32x4 __attribute__((ext_vector_type(4)));
constexpr int BM = 256, BK = 64, HALF = 128, HTB = HALF * BK * 2  , STAGE_BYTES = 8 * HTB, NXCD = 8, WGM = 8;

__host__ __device__ __forceinline__ int lds_byte(int r, int c) { const int st = (r >> 4) * 2 + (c >> 5), rr = r & 15, cc = c & 31, ob = rr * 64 + cc * 2; return st * 1024 + (ob ^ (((ob >> 9) & 1) << 5)); }
__host__ __device__ __forceinline__ void stage_rc(int b, int& R, int& C) { const int st = b / 1024, sb = b % 1024, swz = sb ^ (((sb >> 9) & 1) << 5); R = (st >> 1) * 16 + swz / 64; C = (st & 1) * 32 + (swz % 64) / 2; }
__host__ __device__ __forceinline__ int perm32(int rho) { const int n = rho >> 4, i = rho & 15; return 8 * (i >> 2) + 4 * n + (i & 3); }

struct Unit { int pm, pn; };
struct Gemm { const bf16_t* A; const bf16_t* Bt; int M, N, K; };

struct StaticOrder {
    int nM, nN, nwg, G, c;
    __host__ __device__ void init(int M, int N, int G_, int c_) { nM = M / BM; nN = N / BM; nwg = nM * nN; G = G_; c = c_; }
    __host__ __device__ bool next(int i, Unit& u) const {
        const long L = (long)i * G + c; if (L >= nwg) return false;
        int wgid = (int)L; { const int q = nwg / NXCD, r = nwg % NXCD, xcd = wgid % NXCD, off = wgid / NXCD; wgid = (xcd < r ? xcd * (q + 1) : r * (q + 1) + (xcd - r) * q) + off; }
        const int nig = WGM * nN, gid = wgid / nig, fm = gid * WGM, gsz = (nM - fm) < WGM ? (nM - fm) : WGM;
        u.pm = fm + ((wgid % nig) % gsz); u.pn = (wgid % nig) / gsz; return true;
    }
    __device__ __forceinline__ void a_ready(const Unit&) const {}
    __device__ __forceinline__ void done(const Unit&) const {}
};

__device__ __forceinline__ unsigned cvt_pk_bf16(float lo, float hi) { unsigned r; asm volatile("v_cvt_pk_bf16_f32 %0, %1, %2" : "=v"(r) : "v"(lo), "v"(hi)); return r; }
struct EpiScaleBf16 {
    static constexpr bool PERM = true, AFTER_DRAIN = false;
    bf16_t* O; int ldc; const float* rstd;
    __device__ __forceinline__ void operator()(const f32x4 (&acc)[2][2][4][2], const Unit& u, int wr, int wc, int fr, int fq) const {
        const int row0 = u.pm * BM + wr * 64 + fr, col0 = u.pn * BM + wc * 32 + 8 * fq;
#pragma unroll
        for (int ai = 0; ai < 2; ++ai)
#pragma unroll
            for (int m = 0; m < 4; ++m) { const int row = row0 + ai * HALF + m * 16; const float rs = rstd ? rstd[row] : 1.f; bf16_t* rowp = O + (size_t)row * ldc + col0;
#pragma unroll
                for (int bj = 0; bj < 2; ++bj) { const f32x4 v0 = acc[ai][bj][m][0] * rs, v1 = acc[ai][bj][m][1] * rs;
                    u32x4 w; w.x = cvt_pk_bf16(v0[0], v0[1]); w.y = cvt_pk_bf16(v0[2], v0[3]); w.z = cvt_pk_bf16(v1[0], v1[1]); w.w = cvt_pk_bf16(v1[2], v1[3]);
                    *(u32x4*)(rowp + bj * HALF) = w; } }
    }
};
struct EpiSwiglu {
    static constexpr bool PERM = true, AFTER_DRAIN = false;
    bf16_t* O; int ldc; const float* rstd;
    __device__ __forceinline__ void operator()(const f32x4 (&acc)[2][2][4][2], const Unit& u, int wr, int wc, int fr, int fq) const {
        const int row0 = u.pm * BM + wr * 64 + fr, col0 = u.pn * HALF + wc * 32 + 8 * fq;
#pragma unroll
        for (int ai = 0; ai < 2; ++ai)
#pragma unroll
            for (int m = 0; m < 4; ++m) { const int row = row0 + ai * HALF + m * 16; const float rs = rstd[row]; bf16_t* rowp = O + (size_t)row * ldc + col0;
                float h[8];
#pragma unroll
                for (int n = 0; n < 2; ++n)
#pragma unroll
                    for (int j = 0; j < 4; ++j) { const float g = acc[ai][0][m][n][j] * rs, up = acc[ai][1][m][n][j] * rs;
                        const float e = __builtin_amdgcn_exp2f(g * -1.4426950408889634f); h[n * 4 + j] = g * __builtin_amdgcn_rcpf(1.0f + e) * up; }
                u32x4 w; w.x = cvt_pk_bf16(h[0], h[1]); w.y = cvt_pk_bf16(h[2], h[3]); w.z = cvt_pk_bf16(h[4], h[5]); w.w = cvt_pk_bf16(h[6], h[7]);
                *(u32x4*)rowp = w; }
    }
};
struct EpiRes {
    static constexpr bool PERM = false, AFTER_DRAIN = false;
    const float* base; float* out; int ldc;
    __device__ __forceinline__ void operator()(const f32x4 (&acc)[2][2][4][2], const Unit& u, int wr, int wc, int fr, int fq) const {
        const int row0 = u.pm * BM + wr * 64 + fr, col0 = u.pn * BM + wc * 32 + 4 * fq;
#pragma unroll
        for (int ai = 0; ai < 2; ++ai)
#pragma unroll
            for (int m = 0; m < 4; ++m) { const size_t off = (size_t)(row0 + ai * HALF + m * 16) * ldc + col0;
#pragma unroll
                for (int bj = 0; bj < 2; ++bj)
#pragma unroll
                    for (int n = 0; n < 2; ++n) { const f32x4 bs = *(const f32x4*)(base + off + bj * HALF + n * 16); *(f32x4*)(out + off + bj * HALF + n * 16) = bs + acc[ai][bj][m][n]; } }
    }
};
struct EpiPle {
    static constexpr bool PERM = false, AFTER_DRAIN = false;
    float* h; const bf16_t* pe; int ldc; const float* rstd;
    __device__ __forceinline__ void operator()(const f32x4 (&acc)[2][2][4][2], const Unit& u, int wr, int wc, int fr, int fq) const {
        const int row0 = u.pm * BM + wr * 64 + fr, col0 = u.pn * BM + wc * 32 + 4 * fq;
        typedef unsigned u32x2v __attribute__((ext_vector_type(2)));
#pragma unroll
        for (int ai = 0; ai < 2; ++ai)
#pragma unroll
            for (int m = 0; m < 4; ++m) { const int row = row0 + ai * HALF + m * 16; const float rs = rstd[row]; const size_t off = (size_t)row * ldc + col0;
#pragma unroll
                for (int bj = 0; bj < 2; ++bj)
#pragma unroll
                    for (int n = 0; n < 2; ++n) { const size_t o2 = off + bj * HALF + n * 16; const f32x4 hv = *(const f32x4*)(h + o2); const u32x2v pw = *(const u32x2v*)(pe + o2);
                        const f32x4 a = acc[ai][bj][m][n] * rs; f32x4 pv; pv[0] = __builtin_bit_cast(float, pw.x << 16); pv[1] = __builtin_bit_cast(float, pw.x & 0xffff0000u);
                        pv[2] = __builtin_bit_cast(float, pw.y << 16); pv[3] = __builtin_bit_cast(float, pw.y & 0xffff0000u); f32x4 o;
#pragma unroll
                        for (int j = 0; j < 4; ++j) { const float e = __builtin_amdgcn_exp2f(a[j] * -1.4426950408889634f); o[j] = hv[j] + pv[j] * __builtin_amdgcn_rcpf(1.0f + e); }
                        *(f32x4*)(h + o2) = o; } }
    }
};
template <class Epi, class Sched, bool ALIGN_EPI = false, bool SP2 = false>
__device__ __forceinline__ void gemm_phase(PG8_LAS unsigned char* lds, const Gemm g, const Sched& S, const Epi& E) {
    int tid_ = threadIdx.x; asm volatile("" : "+v"(tid_));
    const int tid = tid_, wid = __builtin_amdgcn_readfirstlane(tid >> 6), lane = tid & 63, wr = wid >> 2, wc = wid & 3, fr = lane & 15, fq = lane >> 4;
    const int K = g.K, nt = K / BK;
    unsigned voffA[2], voffB[2];
#pragma unroll
    for (int i = 0; i < 2; ++i) { int R, C; stage_rc(tid * 16 + i * 8192, R, C); const int Rb = Epi::PERM ? ((R & ~31) + perm32(R & 31)) : R;
        voffA[i] = (unsigned)(R * K + C) * 2u; voffB[i] = (unsigned)(Rb * K + C) * 2u; }
    const size_t kstep = (size_t)(BK * 2);
    const size_t hstep = (size_t)HALF * K * 2;
    const size_t tstep = 2 * hstep;
    const unsigned ldsw = (unsigned)wid * 1024u;
    const int aoff = lds_byte(wr * 64 + fr, fq * 8), boff = lds_byte(wc * 32 + fr, fq * 8);
#define PG8_SA(b, h) (((b) * 2 + (h)) * HTB)
#define PG8_SB(b, h) ((4 + (b) * 2 + (h)) * HTB)
#define PG8_STAGE(bufoff, gbase, voff) do { _Pragma("unroll") for (int _i = 0; _i < 2; ++_i) \
        __builtin_amdgcn_global_load_lds((const unsigned*)((const char*)(gbase) + (voff)[_i]), (PG8_LAS unsigned*)(lds + (bufoff) + ldsw + _i * 8192), 16, 0, 0); } while (0)
#define PG8_LDA(dst, b, h) do { _Pragma("unroll") for (int m = 0; m < 4; ++m) _Pragma("unroll") for (int k = 0; k < 2; ++k) dst[m][k] = *(const PG8_LAS bf16x8*)(lds + PG8_SA(b, h) + aoff + m * 2048 + k * 1024); } while (0)
#define PG8_LDB(dst, b, h) do { _Pragma("unroll") for (int n = 0; n < 2; ++n) _Pragma("unroll") for (int k = 0; k < 2; ++k) dst[n][k] = *(const PG8_LAS bf16x8*)(lds + PG8_SB(b, h) + boff + n * 2048 + k * 1024); } while (0)
#define PG8_MMA(ai, bj, At, Bt) do { __builtin_amdgcn_s_setprio(1); _Pragma("unroll") for (int m = 0; m < 4; ++m) _Pragma("unroll") for (int n = 0; n < 2; ++n) _Pragma("unroll") for (int k = 0; k < 2; ++k) \
        acc[ai][bj][m][n] = __builtin_amdgcn_mfma_f32_16x16x32_bf16(Bt[n][k], At[m][k], acc[ai][bj][m][n], 0, 0, 0); __builtin_amdgcn_s_setprio(0); } while (0)
#define PG8_WAIT_V(n) asm volatile("s_waitcnt vmcnt(" #n ")" ::: "memory")
#define PG8_WAIT_L(n) asm volatile("s_waitcnt lgkmcnt(" #n ")" ::: "memory")
#define PG8_BAR __builtin_amdgcn_s_barrier()
#define PG8_SCHED __builtin_amdgcn_sched_barrier(0)
    Unit cur, nxt; int ui = 0;
    if (!S.next(0, cur)) return;
    f32x4 acc[2][2][4][2];
#pragma unroll
    for (int a = 0; a < 2; ++a)
#pragma unroll
        for (int b = 0; b < 2; ++b)
#pragma unroll
            for (int m = 0; m < 4; ++m)
#pragma unroll
                for (int n = 0; n < 2; ++n) acc[a][b][m][n] = (f32x4){0.f, 0.f, 0.f, 0.f};
    bf16x8 At[4][2], B0[2][2], B1[2][2];
    const char* cA = (const char*)g.A + (size_t)cur.pm * tstep; const char* cB = (const char*)g.Bt + (size_t)cur.pn * tstep;
    S.a_ready(cur);
    if constexpr (SP2) {
        PG8_STAGE(PG8_SB(0, 0), cB, voffB); PG8_STAGE(PG8_SB(0, 1), cB + hstep, voffB); PG8_STAGE(PG8_SA(0, 0), cA, voffA); PG8_STAGE(PG8_SA(0, 1), cA + hstep, voffA);
        if (wr == 1) PG8_BAR;
        PG8_WAIT_V(2); PG8_BAR;
        PG8_STAGE(PG8_SB(1, 0), cB + kstep, voffB); PG8_STAGE(PG8_SA(1, 0), cA + kstep, voffA); PG8_STAGE(PG8_SB(1, 1), cB + hstep + kstep, voffB);
        PG8_WAIT_V(6); PG8_BAR;
    } else {
        PG8_STAGE(PG8_SB(0, 0), cB, voffB); PG8_STAGE(PG8_SA(0, 0), cA, voffA); PG8_STAGE(PG8_SB(0, 1), cB + hstep, voffB); PG8_STAGE(PG8_SA(0, 1), cA + hstep, voffA);
        if (wr == 1) PG8_BAR;
        PG8_WAIT_V(4); PG8_BAR;
        PG8_STAGE(PG8_SB(1, 0), cB + kstep, voffB); PG8_STAGE(PG8_SA(1, 0), cA + kstep, voffA); PG8_STAGE(PG8_SB(1, 1), cB + hstep + kstep, voffB);
        PG8_WAIT_V(6); PG8_BAR;
    }
    for (;;) {
        const bool has_next = S.next(ui + 1, nxt);
        const char* nA = has_next ? (const char*)g.A + (size_t)nxt.pm * tstep : cA; const char* nB = has_next ? (const char*)g.Bt + (size_t)nxt.pn * tstep : cB;
        for (int t = 0; t < nt; t += 2) {
            const bool last = (t == nt - 2);
            const char* a1 = cA + (size_t)(t + 1) * kstep;
            const char* a2 = last ? nA : cA + (size_t)(t + 2) * kstep; const char* b2 = last ? nB : cB + (size_t)(t + 2) * kstep;
            const char* a3 = a2 + kstep; const char* b3 = b2 + kstep;
            if (last && has_next) S.a_ready(nxt);
            if constexpr (SP2) {
            PG8_LDB(B0, 0, 0); PG8_LDB(B1, 0, 1); PG8_SCHED; PG8_LDA(At, 0, 0); PG8_STAGE(PG8_SA(1, 1), a1 + hstep, voffA);
            PG8_WAIT_V(8); PG8_WAIT_L(0); PG8_BAR; PG8_MMA(0, 0, At, B0); PG8_MMA(0, 1, At, B1); PG8_BAR; PG8_SCHED;
            PG8_LDA(At, 0, 1); PG8_STAGE(PG8_SB(0, 0), b2, voffB); PG8_STAGE(PG8_SB(0, 1), b2 + hstep, voffB); PG8_STAGE(PG8_SA(0, 0), a2, voffA);
            PG8_WAIT_V(8); PG8_WAIT_L(0); PG8_BAR; PG8_MMA(1, 0, At, B0); PG8_MMA(1, 1, At, B1); PG8_BAR; PG8_SCHED;
            PG8_LDB(B0, 1, 0); PG8_LDB(B1, 1, 1); PG8_SCHED; PG8_LDA(At, 1, 0); PG8_STAGE(PG8_SA(0, 1), a2 + hstep, voffA);
            PG8_WAIT_V(8); PG8_WAIT_L(0); PG8_BAR; PG8_MMA(0, 0, At, B0); PG8_MMA(0, 1, At, B1); PG8_BAR; PG8_SCHED;
            PG8_LDA(At, 1, 1); PG8_STAGE(PG8_SB(1, 0), b3, voffB); PG8_STAGE(PG8_SB(1, 1), b3 + hstep, voffB); PG8_STAGE(PG8_SA(1, 0), a3, voffA);
            PG8_WAIT_V(8); PG8_WAIT_L(0); PG8_BAR; PG8_MMA(1, 0, At, B0); PG8_MMA(1, 1, At, B1); PG8_BAR; PG8_SCHED;
            } else {
            PG8_LDB(B0, 0, 0); PG8_SCHED; PG8_LDA(At, 0, 0); PG8_STAGE(PG8_SA(1, 1), a1 + hstep, voffA);
            PG8_WAIT_L(8); PG8_BAR; PG8_WAIT_L(0); PG8_MMA(0, 0, At, B0); PG8_BAR; PG8_SCHED;
            PG8_LDB(B1, 0, 1); PG8_STAGE(PG8_SB(0, 0), b2, voffB);
            PG8_BAR; PG8_WAIT_L(0); PG8_MMA(0, 1, At, B1); PG8_BAR;
            PG8_LDA(At, 0, 1); PG8_STAGE(PG8_SA(0, 0), a2, voffA);
            PG8_BAR; PG8_WAIT_L(0); PG8_MMA(1, 0, At, B0); PG8_BAR; PG8_SCHED;
            PG8_STAGE(PG8_SB(0, 1), b2 + hstep, voffB);
            PG8_WAIT_V(6); PG8_BAR; PG8_MMA(1, 1, At, B1); PG8_BAR;
            PG8_LDB(B0, 1, 0); PG8_SCHED; PG8_LDA(At, 1, 0); PG8_STAGE(PG8_SA(0, 1), a2 + hstep, voffA);
            PG8_WAIT_L(8); PG8_BAR; PG8_WAIT_L(0); PG8_MMA(0, 0, At, B0); PG8_BAR; PG8_SCHED;
            PG8_LDB(B1, 1, 1); PG8_STAGE(PG8_SB(1, 0), b3, voffB);
            PG8_BAR; PG8_WAIT_L(0); PG8_MMA(0, 1, At, B1); PG8_BAR;
            PG8_LDA(At, 1, 1); PG8_STAGE(PG8_SA(1, 0), a3, voffA);
            PG8_BAR; PG8_WAIT_L(0); PG8_MMA(1, 0, At, B0); PG8_BAR; PG8_SCHED;
            PG8_STAGE(PG8_SB(1, 1), b3 + hstep, voffB);
            PG8_WAIT_V(6); PG8_BAR; PG8_MMA(1, 1, At, B1); PG8_BAR;
            }
        }
        if constexpr (ALIGN_EPI) { if (wr == 0) PG8_BAR; }
        if constexpr (!Epi::AFTER_DRAIN) { E(acc, cur, wr, wc, fr, fq); S.done(cur); }
        if (!has_next) break;
#pragma unroll
        for (int a = 0; a < 2; ++a)
#pragma unroll
            for (int b = 0; b < 2; ++b)
#pragma unroll
                for (int m = 0; m < 4; ++m)
#pragma unroll
                    for (int n = 0; n < 2; ++n) acc[a][b][m][n] = (f32x4){0.f, 0.f, 0.f, 0.f};
        cur = nxt; cA = nA; cB = nB; ++ui;
        if constexpr (ALIGN_EPI) { if (wr == 1) PG8_BAR; }
    }
    PG8_WAIT_V(0);
    if constexpr (!ALIGN_EPI) { if (wr == 0) PG8_BAR; }
    PG8_BAR;
    if constexpr (Epi::AFTER_DRAIN) { E.fused(acc, cur, wr, wc, fr, fq, lds, wid, lane); S.done(cur); }
#undef PG8_SA
#undef PG8_SB
#undef PG8_STAGE
#undef PG8_LDA
#undef PG8_LDB
#undef PG8_MMA
#undef PG8_WAIT_V
#undef PG8_WAIT_L
#undef PG8_BAR
#undef PG8_SCHED
}
}
#define XB_TMO      128
#define XB_XCNT(j)  (256  + 64 * (j))
#define XB_XSUB(j)  (1280 + 64 * (j))
#define XB_XGEN(j)  (2304 + 64 * (j))
#define XB_TOP      3328
#define XB_TOPGEN   3392
#define XCD_BAR_WORDS 3456
#define XB_SPIN_CAP (1u << 18)

__device__ __forceinline__ unsigned xb_ld(unsigned* p)              { return __hip_atomic_load(p, __ATOMIC_RELAXED, __HIP_MEMORY_SCOPE_AGENT); }
__device__ __forceinline__ unsigned xb_add(unsigned* p, unsigned v) { return __hip_atomic_fetch_add(p, v, __ATOMIC_RELAXED, __HIP_MEMORY_SCOPE_AGENT); }
__device__ __forceinline__ unsigned xb_xcc_id() { return (unsigned)__builtin_amdgcn_s_getreg((3 << 11) | 20) & 0xFu; }
#define XB_SPIN(cond, bar) do { unsigned _sp = 0; while (cond) { __builtin_amdgcn_s_sleep(1); \
    if ((++_sp & 255u) == 0u) { if (xb_ld(&(bar)[XB_TMO])) break; if (_sp > XB_SPIN_CAP) { atomicAdd(&(bar)[XB_TMO], 1u); break; } } } } while (0)

struct XcdBarrier {
    unsigned* bar; unsigned x;
    volatile LAS unsigned* st;
};

__device__ __forceinline__ XcdBarrier xcd_barrier_post(unsigned* bar, volatile LAS unsigned* st) {
    XcdBarrier b; b.bar = bar; b.x = xb_xcc_id(); b.st = st;
    if (threadIdx.x == 0) (void)xb_add(&bar[XB_XCNT(b.x)], 1u);
    return b;
}
__device__ __forceinline__ void xcd_barrier_complete(unsigned* bar, unsigned x, unsigned& nloc, unsigned& nx) {
    const unsigned G = gridDim.x * gridDim.y * gridDim.z;
    unsigned sum, cnt, mine, sp = 0u;
    for (;;) {
        sum = 0u; cnt = 0u; mine = 0u;
#pragma unroll
        for (unsigned j = 0; j < 16; ++j) { const unsigned c = xb_ld(&bar[XB_XCNT(j)]); sum += c; cnt += (c > 0u) ? 1u : 0u; mine = (j == x) ? c : mine; }
        if (sum == G) break;
        __builtin_amdgcn_s_sleep(1);
        if ((++sp & 255u) == 0u) { if (xb_ld(&bar[XB_TMO])) break; if (sp > XB_SPIN_CAP) { atomicAdd(&bar[XB_TMO], 1u); break; } }
    }
    nloc = mine > 0u ? mine : 1u; nx = cnt > 0u ? cnt : 1u;
}

__device__ __forceinline__ void xcd_barrier(const XcdBarrier& b) {
    asm volatile("s_waitcnt vmcnt(0)" ::: "memory");
    __syncthreads();
    if (threadIdx.x == 0) {
        unsigned* bar = b.bar;
        __builtin_amdgcn_s_waitcnt(0);
        unsigned nloc = b.st[0], nx = b.st[1];
        if (nloc == 0u) { xcd_barrier_complete(bar, b.x, nloc, nx); b.st[0] = nloc; b.st[1] = nx; }
        const unsigned old = xb_add(&bar[XB_XSUB(b.x)], 1u);
        const unsigned gen = old / nloc;
        if (old + 1u == (gen + 1u) * nloc) {
            __builtin_amdgcn_fence(__ATOMIC_RELEASE, "agent");
            asm volatile("s_waitcnt vmcnt(0)" ::: "memory");
            const unsigned og = xb_add(&bar[XB_TOP], 1u);
            const unsigned tg = og / nx;
            if (og + 1u == (tg + 1u) * nx) xb_add(&bar[XB_TOPGEN], 1u);
            else XB_SPIN(xb_ld(&bar[XB_TOPGEN]) == tg, bar);
            __builtin_amdgcn_fence(__ATOMIC_ACQUIRE, "agent");
            xb_add(&bar[XB_XGEN(b.x)], 1u);
            asm volatile("s_waitcnt vmcnt(0)" ::: "memory");
        } else {
            XB_SPIN(xb_ld(&bar[XB_XGEN(b.x)]) == gen, bar);
            __builtin_amdgcn_fence(__ATOMIC_ACQUIRE, "agent");
            asm volatile("s_waitcnt vmcnt(0)" ::: "memory");
        }
    }
    __syncthreads();
}
struct Frame {
    LAS unsigned char* lds;
    volatile LAS unsigned* MISC;
    gu32* ctl;
    int tid, lane, wave, vcu, G;
    const float* in[19]; float* out; unsigned char* ws;
};
__device__ __forceinline__ float wave_sum(float v) {
#pragma unroll
    for (int o = 1; o < 64; o <<= 1) v += __shfl_xor(v, o);
    return v;
}
__device__ __forceinline__ void p0_item(const float* W, int ldw, int k0, int n0, const float* gain, bf16* WT, int ldk, int drow0, LAS float* scr, int lane) {
#pragma unroll 8
    for (int i = 0; i < 32; ++i) { const int kk = 2 * i + (lane >> 5); float v = W[(size_t)(k0 + kk) * ldw + n0 + (lane & 31)]; if (gain) v *= gain[k0 + kk]; scr[kk * 33 + (lane & 31)] = v; }
    LDS_WAIT(); asm volatile("" ::: "memory");
    const int c = lane & 7;
#pragma unroll
    for (int j = 0; j < 4; ++j) { const int n = (lane >> 3) + 8 * j; const LAS float* s = scr + (8 * c) * 33 + n;
        v4u o; o.x = pk2(s[0 * 33], s[1 * 33]); o.y = pk2(s[2 * 33], s[3 * 33]); o.z = pk2(s[4 * 33], s[5 * 33]); o.w = pk2(s[6 * 33], s[7 * 33]);
        *(GAS v4u*)(WT + (size_t)(drow0 + n) * ldk + k0 + 8 * c) = o; }
    LDS_WAIT(); asm volatile("" ::: "memory");
}
__device__ __forceinline__ void p0_matrix_item(const float* W, int K, int N, const float* gain, bf16* WT, int mode, int item, LAS float* scr, int lane) {
    const int nblk = N / 32, kb = item / nblk, nb = item % nblk, n0 = 32 * nb;
    const int drow0 = mode == 0 ? n0 : (256 * (n0 >> 7) + (n0 & 127) + (mode == 2 ? 128 : 0));
    p0_item(W, N, 64 * kb, n0, gain, WT, K, drow0, scr, lane);
}
__device__ __forceinline__ void norm_row(Frame& F, const float* xrow, bf16* orow, float* rstd_out) {
    const GAS f32x4* xr = (const GAS f32x4*)xrow + F.lane;
    f32x4 v[8]; float s = 0.f;
#pragma unroll
    for (int j = 0; j < 8; ++j) { v[j] = xr[64 * j]; s += (v[j].x * v[j].x + v[j].y * v[j].y) + (v[j].z * v[j].z + v[j].w * v[j].w); }
    s = wave_sum(s);
    if (F.lane == 0) *rstd_out = 1.0f / sqrtf(s * (1.f / DM) + EPS);
    GAS v2u* o8 = (GAS v2u*)orow + F.lane;
#pragma unroll
    for (int j = 0; j < 8; ++j) { v2u w; w.x = pk2(v[j].x, v[j].y); w.y = pk2(v[j].z, v[j].w); o8[64 * j] = w; }
}
__device__ __forceinline__ void norm_phase(Frame& F, const float* h) {
    const int gw = F.vcu * NWAVES + F.wave, NGW = F.G * NWAVES;
    bf16* HB = (bf16*)(F.ws + WS_HB); float* RS = (float*)(F.ws + WS_RSTD);
    for (int m = gw; m < MT; m += NGW) norm_row(F, h + (size_t)m * DM, HB + (size_t)m * DM, RS + m);
}
__device__ __forceinline__ void final_norm_phase(Frame& F) {
    const int gw = F.vcu * NWAVES + F.wave, NGW = F.G * NWAVES;
    const float* g = F.in[18];
    f32x4 gv[8];
#pragma unroll
    for (int j = 0; j < 8; ++j) gv[j] = ((const GAS f32x4*)g)[F.lane + 64 * j];
    for (int m = gw; m < MT; m += NGW) {
        GAS f32x4* xr = (GAS f32x4*)(F.out + (size_t)m * DM) + F.lane;
        f32x4 v[8]; float s = 0.f;
#pragma unroll
        for (int j = 0; j < 8; ++j) { v[j] = xr[64 * j]; s += (v[j].x * v[j].x + v[j].y * v[j].y) + (v[j].z * v[j].z + v[j].w * v[j].w); }
        s = wave_sum(s);
        const float rs = 1.0f / sqrtf(s * (1.f / DM) + EPS);
#pragma unroll
        for (int j = 0; j < 8; ++j) xr[64 * j] = v[j] * rs * gv[j];
    }
}
__device__ __forceinline__ void p0_prologue(Frame& F) {
    LAS float* scr = (LAS float*)(F.lds + RING_OFF + F.wave * 16384);
    const int gw = F.vcu * NWAVES + F.wave, NGW = F.G * NWAVES;
    unsigned char* ws = F.ws;
    constexpr int I_IN0 = (DM / 64) * (EVEN_IN / 32), I_SQ = (DM / 64) * (DM / 32), I_IN1 = (DM / 64) * (LDQKV / 32), I_GU = (DM / 64) * (FF / 32), I_D = (FF / 64) * (DM / 32), I_PE = (PLE / 64) * (DM / 32);
    constexpr int NITEMS = I_IN0 + I_SQ + I_IN1 + I_SQ + 2 * (2 * I_GU + I_D + I_SQ + I_PE);
    for (int it = gw; it < NITEMS; it += NGW) {
        int r = it;
        if (r < I_IN0) { p0_matrix_item(F.in[3], DM, EVEN_IN, F.in[2], (bf16*)(ws + WS_WIN0), 0, r, scr, F.lane); continue; } r -= I_IN0;
        if (r < I_SQ) { p0_matrix_item(F.in[7], DM, DM, nullptr, (bf16*)(ws + WS_WOUT0), 0, r, scr, F.lane); continue; } r -= I_SQ;
        if (r < I_IN1) { p0_matrix_item(F.in[9], DM, LDQKV, F.in[8], (bf16*)(ws + WS_WIN1), 0, r, scr, F.lane); continue; } r -= I_IN1;
        if (r < I_SQ) { p0_matrix_item(F.in[10], DM, DM, nullptr, (bf16*)(ws + WS_WOUT1), 0, r, scr, F.lane); continue; } r -= I_SQ;
        constexpr int PERL = 2 * I_GU + I_D + I_SQ + I_PE;
        const int l = r >= PERL ? 1 : 0; r -= l * PERL;
        if (r < I_GU) { p0_matrix_item(F.in[12] + (size_t)l * DM * FF, DM, FF, F.in[11] + l * DM, (bf16*)(ws + WS_WGU + (size_t)l * 44 * MiB), 1, r, scr, F.lane); continue; } r -= I_GU;
        if (r < I_GU) { p0_matrix_item(F.in[13] + (size_t)l * DM * FF, DM, FF, F.in[11] + l * DM, (bf16*)(ws + WS_WGU + (size_t)l * 44 * MiB), 2, r, scr, F.lane); continue; } r -= I_GU;
        if (r < I_D) { p0_matrix_item(F.in[14] + (size_t)l * FF * DM, FF, DM, nullptr, (bf16*)(ws + WS_WD + (size_t)l * 22 * MiB), 0, r, scr, F.lane); continue; } r -= I_D;
        if (r < I_SQ) { p0_matrix_item(F.in[16] + (size_t)l * DM * DM, DM, DM, F.in[15] + l * DM, (bf16*)(ws + WS_WPG + (size_t)l * 8 * MiB), 0, r, scr, F.lane); continue; } r -= I_SQ;
        p0_matrix_item(F.in[17] + (size_t)l * PLE * DM, PLE, DM, nullptr, (bf16*)(ws + WS_WPE + (size_t)l * 1 * MiB), 0, r, scr, F.lane);
    }
    { GAS v4u* z = (GAS v4u*)(ws + WS_WIN0 + (size_t)EVEN_IN * DM * 2); const int n16 = 32 * DM * 2 / 16;
      for (int i = F.vcu * 512 + F.tid; i < n16; i += F.G * 512) z[i] = (v4u){0u, 0u, 0u, 0u}; }
    { const GAS f32x4* ps = (const GAS f32x4*)F.in[1]; GAS v4u* pd = (GAS v4u*)(ws + WS_PB); const size_t n8 = (size_t)2 * MT * PLE / 8;
      for (size_t i = (size_t)F.vcu * 512 + F.tid; i < n8; i += (size_t)F.G * 512) { const f32x4 a = ps[2 * i], b = ps[2 * i + 1];
          v4u o; o.x = pk2(a.x, a.y); o.y = pk2(a.z, a.w); o.z = pk2(b.x, b.y); o.w = pk2(b.z, b.w); pd[i] = o; } }
    norm_phase(F, F.in[0]);
}
__device__ __forceinline__ unsigned mono_key(float f) { const unsigned u = __builtin_bit_cast(unsigned, f); return (u & 0x80000000u) ? ~u : (u | 0x80000000u); }
__device__ __forceinline__ float block_reduce_sum_256(float v, float* red) {
    v = wave_sum(v); __syncthreads(); if ((threadIdx.x & 63) == 0) red[threadIdx.x >> 6] = v; __syncthreads(); return red[0] + red[1] + red[2] + red[3];
}
__global__ void __launch_bounds__(256) naive_dsa(const bf16* __restrict__ u, bf16* __restrict__ obuf, unsigned* __restrict__ maskw, int mode) {
    __shared__ float qi[16 * 64]; __shared__ float wi[16]; __shared__ float sc[2048]; __shared__ unsigned char sel[2048]; __shared__ int sidx[256];
    __shared__ float qa[8 * 128]; __shared__ float lg[8 * 256]; __shared__ float red[8]; __shared__ int cnt_s; __shared__ float hs[16];
    const int tok = blockIdx.x, b = tok >> 11, t = tok & 2047, tid = threadIdx.x; const int limit = ((t >> 6) + 1) << 6;
    const bf16* ur = u + (size_t)tok * LDU;
    for (int i = tid; i < 1024; i += 256) { qi[i] = bf2f(ur[U_QI + i]); qa[i] = bf2f(ur[U_QA + i]); }
    if (tid < 16) wi[tid] = bf2f(ur[U_WI + tid]);
    __syncthreads();
    for (int s = tid; s < limit; s += 256) {
        const bf16* kr = u + (size_t)(b * SEQ + s) * LDU + U_KI; float kf[64];
#pragma unroll
        for (int d = 0; d < 64; ++d) kf[d] = bf2f(kr[d]);
        float acc = 0.f;
        for (int h = 0; h < 16; ++h) { float dot = 0.f;
#pragma unroll
            for (int d = 0; d < 64; ++d) dot += qi[h * 64 + d] * kf[d];
            acc += wi[h] * fmaxf(dot, 0.f); }
        sc[s] = acc * (1.0f / 32.0f); sel[s] = 0;
    }
    __syncthreads();
    if (mode == 1) { for (int s = tid; s < limit; s += 256) sel[s] = (maskw[(size_t)tok * 64 + (s >> 5)] >> (s & 31)) & 1u; }
    else if (limit <= 256) { for (int s = tid; s < limit; s += 256) sel[s] = 1; }
    else {
        unsigned tau = 0;
        for (int bit = 31; bit >= 0; --bit) {
            const unsigned cand = tau | (1u << bit); int c = 0;
            for (int s = tid; s < limit; s += 256) c += (mono_key(sc[s]) >= cand) ? 1 : 0;
            const float tot = block_reduce_sum_256((float)c, red);
            if (tot >= 256.f) tau = cand;
        }
        int c = 0;
        for (int s = tid; s < limit; s += 256) { const bool g = mono_key(sc[s]) > tau; sel[s] = g ? 1 : 0; c += g ? 1 : 0; }
        const float cgt = block_reduce_sum_256((float)c, red);
        __syncthreads();
        if (tid == 0) { int rem = 256 - (int)cgt; for (int s = 0; s < limit && rem > 0; ++s) if (mono_key(sc[s]) == tau) { sel[s] = 1; --rem; } }
    }
    __syncthreads();
    if (tid == 0) { int p = 0; for (int s = 0; s < limit; ++s) if (sel[s] && p < 256) sidx[p++] = s; cnt_s = p; }
    if (mode == 0 && tid < 64) { unsigned w = 0u; for (int k = 0; k < 32; ++k) { const int s = tid * 32 + k; if (s < limit && sel[s]) w |= 1u << k; } maskw[(size_t)tok * 64 + tid] = w; }
    __syncthreads();
    const int nsel = cnt_s < 256 ? cnt_s : 256;
    if (tid < nsel) { const bf16* cr = u + (size_t)(b * SEQ + sidx[tid]) * LDU + U_CA; float cf[128];
#pragma unroll
        for (int d = 0; d < 128; ++d) cf[d] = bf2f(cr[d]);
        for (int h = 0; h < 8; ++h) { float dot = 0.f;
#pragma unroll
            for (int d = 0; d < 128; ++d) dot += qa[h * 128 + d] * cf[d];
            lg[h * 256 + tid] = dot * 0.08838834764831845f; } }
    __syncthreads();
    { const int w = tid >> 6, lane = tid & 63;
      for (int hh = 0; hh < 2; ++hh) { const int h = 2 * w + hh; float mx = -1e30f;
          for (int k = lane; k < nsel; k += 64) mx = fmaxf(mx, lg[h * 256 + k]);
#pragma unroll
          for (int o = 1; o < 64; o <<= 1) mx = fmaxf(mx, __shfl_xor(mx, o));
          float sm = 0.f;
          for (int k = lane; k < nsel; k += 64) { const float e = __expf(lg[h * 256 + k] - mx); lg[h * 256 + k] = e; sm += e; }
          sm = wave_sum(sm);
          if (lane == 0) hs[h] = 1.0f / sm; } }
    __syncthreads();
    { const int h = tid >> 5, d0 = (tid & 31) * 4; float o0 = 0.f, o1 = 0.f, o2 = 0.f, o3 = 0.f;
      for (int k = 0; k < nsel; ++k) { const bf16* cr = u + (size_t)(b * SEQ + sidx[k]) * LDU + U_CA + d0; const float p = lg[h * 256 + k];
          o0 += p * bf2f(cr[0]); o1 += p * bf2f(cr[1]); o2 += p * bf2f(cr[2]); o3 += p * bf2f(cr[3]); }
      const float inv = hs[h]; bf16* op = obuf + (size_t)tok * DM + h * 128 + d0;
      op[0] = (bf16)f2bf(o0 * inv); op[1] = (bf16)f2bf(o1 * inv); op[2] = (bf16)f2bf(o2 * inv); op[3] = (bf16)f2bf(o3 * inv); }
}
__global__ void __launch_bounds__(256) naive_gla(const bf16* __restrict__ u, const float* __restrict__ w_gk, const float* __restrict__ b_gk, float* __restrict__ oraw) {
    __shared__ float ks[16][128], qs[16][128], dc[16][128], vs[16][64], lr[16][16], po[16][4][64];
    const int bh = blockIdx.x >> 2, slice = blockIdx.x & 3, b = bh >> 2, h = bh & 3, tid = threadIdx.x, j = tid & 63, qd = tid >> 6;
    float S[32];
#pragma unroll
    for (int i = 0; i < 32; ++i) S[i] = 0.f;
    for (int t0 = 0; t0 < SEQ; t0 += 16) {
        __syncthreads();
        { const int tt = tid >> 4, r = tid & 15; lr[tt][r] = bf2f(u[(size_t)(b * SEQ + t0 + tt) * LDU + U_LR + r]); }
        for (int i = tid; i < 16 * 128; i += 256) { const int tt = i >> 7, d = i & 127; const bf16* ur = u + (size_t)(b * SEQ + t0 + tt) * LDU;
            ks[tt][d] = bf2f(ur[U_KB + h * 128 + d]); qs[tt][d] = bf2f(ur[U_QB + h * 128 + d]); }
        for (int i = tid; i < 16 * 64; i += 256) { const int tt = i >> 6, c = i & 63; vs[tt][c] = bf2f(u[(size_t)(b * SEQ + t0 + tt) * LDU + U_VB + h * 256 + slice * 64 + c]); }
        __syncthreads();
        for (int i = tid; i < 16 * 128; i += 256) { const int tt = i >> 7, d = i & 127; float x = b_gk[h * 128 + d];
#pragma unroll
            for (int r = 0; r < 16; ++r) x += lr[tt][r] * w_gk[r * 512 + h * 128 + d];
            const float ls = -(fmaxf(-x, 0.f) + log1pf(__expf(-fabsf(x)))); dc[tt][d] = __expf(ls * (1.0f / 16.0f)); }
        __syncthreads();
        for (int tt = 0; tt < 16; ++tt) { const float v = vs[tt][j]; float part = 0.f;
#pragma unroll
            for (int i = 0; i < 32; ++i) { const int d = 32 * qd + i; S[i] = S[i] * dc[tt][d] + ks[tt][d] * v; part += qs[tt][d] * S[i]; }
            po[tt][qd][j] = part; }
        __syncthreads();
        for (int i = tid; i < 16 * 64; i += 256) { const int tt = i >> 6, c = i & 63;
            oraw[(size_t)(b * SEQ + t0 + tt) * 1024 + h * 256 + slice * 64 + c] = (po[tt][0][c] + po[tt][1][c] + po[tt][2][c] + po[tt][3][c]) * 0.08838834764831845f; }
    }
}
__global__ void __launch_bounds__(256) naive_gla_norm(const float* __restrict__ oraw, const bf16* __restrict__ u, const float* __restrict__ gain, bf16* __restrict__ obuf) {
    const int gw = (blockIdx.x * 256 + threadIdx.x) >> 6, lane = threadIdx.x & 63; if (gw >= MT * 4) return;
    const int tok = gw >> 2, h = gw & 3; const float* o = oraw + (size_t)tok * 1024 + h * 256 + lane * 4;
    const float a0 = o[0], a1 = o[1], a2 = o[2], a3 = o[3]; const float ss = wave_sum(a0 * a0 + a1 * a1 + a2 * a2 + a3 * a3);
    const float rs = 1.0f / sqrtf(ss * (1.0f / 256.0f) + EPS); const bf16* g = u + (size_t)tok * LDU + U_GB + h * 256 + lane * 4; const float* gn = gain + lane * 4;
    bf16* op = obuf + (size_t)tok * DM + 1024 + h * 256 + lane * 4; const float av[4] = {a0, a1, a2, a3};
#pragma unroll
    for (int i = 0; i < 4; ++i) { const float gg = bf2f(g[i]); const float si = gg / (1.0f + __expf(-gg)); op[i] = (bf16)f2bf(av[i] * rs * gn[i] * si); }
}
__global__ void __launch_bounds__(256) naive_sb(const bf16* __restrict__ qkv, bf16* __restrict__ obuf) {
    __shared__ float qs[4][128];
    const int w = threadIdx.x >> 6, lane = threadIdx.x & 63; const int gq = blockIdx.x * 4 + w;
    const int t = gq & 2047, h = (gq >> 11) & 15, b = gq >> 15;
    const bf16* qr = qkv + (size_t)(b * SEQ + t) * LDQKV + h * 128;
    qs[w][lane] = bf2f(qr[lane]); qs[w][lane + 64] = bf2f(qr[lane + 64]);
    __syncthreads();
    float o0 = 0.f, o1 = 0.f, R = 0.f;
    for (int jt = (t - 1) >> 6; jt >= 0 && t > 0; --jt) {
        const int s = jt * 64 + lane; const bool valid = s < t;
        const bf16* kr = qkv + (size_t)(b * SEQ + s) * LDQKV + 2048 + h * 128; float dot = 0.f;
#pragma unroll 8
        for (int d = 0; d < 128; ++d) dot += qs[w][d] * bf2f(kr[d]);
        const float z = dot * 0.08838834764831845f;
        const float sp = fmaxf(z, 0.f) + log1pf(__expf(-fabsf(z)));
        const float l = valid ? -sp : 0.f, lb = z - sp;
        float inc = l;
#pragma unroll
        for (int o = 1; o < 64; o <<= 1) { const float y = __shfl_down(inc, o); if (lane + o < 64) inc += y; }
        const float suf = inc - l;
        const float wgt = valid ? __expf(R + suf + lb) : 0.f;
        R += __shfl(inc, 0);
        for (int k = 0; k < 64; ++k) { const float wk = __shfl(wgt, k); const bf16* vr = qkv + (size_t)(b * SEQ + jt * 64 + k) * LDQKV + 4096 + h * 128 + lane * 2;
            o0 += wk * bf2f(vr[0]); o1 += wk * bf2f(vr[1]); }
    }
    bf16* op = obuf + (size_t)(b * SEQ + t) * DM + h * 128 + lane * 2; op[0] = (bf16)f2bf(o0); op[1] = (bf16)f2bf(o1);
}
namespace att {
typedef unsigned u32x4v __attribute__((ext_vector_type(4)));
constexpr int TILE_B = 64 * 128 * 2;
constexpr int K_OFF = 0, V_OFF = 2 * TILE_B, WS_OFF = 4 * TILE_B;
constexpr int FLAG_OFF = WS_OFF + 8 * 64 * 4;
#define ATT_KSWZ(row, colB) ((row) * 256 + ((colB) ^ (((row) & 7) << 4)))
#define ATT_SBAR() __builtin_amdgcn_sched_barrier(0)
__device__ __forceinline__ int crow(int r, int hi) { return (r & 3) + 8 * (r >> 2) + 4 * hi; }
__device__ __forceinline__ unsigned cvtpk(float lo, float hi) { unsigned r; asm volatile("v_cvt_pk_bf16_f32 %0, %1, %2" : "=v"(r) : "v"(lo), "v"(hi)); return r; }
__device__ __forceinline__ int v_st(int k, int c) { const int kk = (k & ~0xC) | ((k & 4) << 1) | ((k & 8) >> 1); return ((kk >> 3) * 4 + (c >> 5)) * 512 + ((kk & 7) * 32 + (c & 31)) * 2; }
__device__ __forceinline__ int v_rd_base(int lane) { return ((lane & 3) << 3) | (((lane >> 2) & 3) << 6) | (((lane >> 4) & 1) << 5) | (((lane >> 5) & 1) << 8); }
constexpr int v_rd_off(int d0, int ks, int half) { return d0 * 512 + ks * 4096 + half * 2048; }
template <int OFF> __device__ __forceinline__ s16x4 tr_read(int vb) { s16x4 r; asm volatile("ds_read_b64_tr_b16 %0, %1 offset:%2" : "=&v"(r) : "v"(vb), "i"(OFF) : "memory"); return r; }
template <int D0> __device__ __forceinline__ void pv_one(f32x16& od, int vb, bf16x8 pa0, bf16x8 pa1, bf16x8 pa2, bf16x8 pa3) {
    const s16x4 l0 = tr_read<v_rd_off(D0, 0, 0)>(vb), h0 = tr_read<v_rd_off(D0, 0, 1)>(vb), l1 = tr_read<v_rd_off(D0, 1, 0)>(vb), h1 = tr_read<v_rd_off(D0, 1, 1)>(vb);
    const s16x4 l2 = tr_read<v_rd_off(D0, 2, 0)>(vb), h2 = tr_read<v_rd_off(D0, 2, 1)>(vb), l3 = tr_read<v_rd_off(D0, 3, 0)>(vb), h3 = tr_read<v_rd_off(D0, 3, 1)>(vb);
    asm volatile("s_waitcnt lgkmcnt(0)" ::: "memory"); ATT_SBAR();
#define ATT_PK(L, H) (bf16x8){L[0], L[1], L[2], L[3], H[0], H[1], H[2], H[3]}
    od = __builtin_amdgcn_mfma_f32_32x32x16_bf16(pa0, ATT_PK(l0, h0), od, 0, 0, 0);
    od = __builtin_amdgcn_mfma_f32_32x32x16_bf16(pa1, ATT_PK(l1, h1), od, 0, 0, 0);
    od = __builtin_amdgcn_mfma_f32_32x32x16_bf16(pa2, ATT_PK(l2, h2), od, 0, 0, 0);
    od = __builtin_amdgcn_mfma_f32_32x32x16_bf16(pa3, ATT_PK(l3, h3), od, 0, 0, 0);
#undef ATT_PK
}
__device__ __forceinline__ void pv_d0(f32x16* o, int vb, bf16x8 pa0, bf16x8 pa1, bf16x8 pa2, bf16x8 pa3) {
    pv_one<0>(o[0], vb, pa0, pa1, pa2, pa3); pv_one<1>(o[1], vb, pa0, pa1, pa2, pa3); pv_one<2>(o[2], vb, pa0, pa1, pa2, pa3); pv_one<3>(o[3], vb, pa0, pa1, pa2, pa3);
}
__device__ __forceinline__ void qkt(f32x16& p0, f32x16& p1, LAS const unsigned char* Ks, const bf16x8* qr, int r32, int hi) {
    p0 = f32x16{}; p1 = f32x16{};
#pragma unroll
    for (int d0 = 0; d0 < 8; ++d0) { const int cb = (d0 * 16 + hi * 8) * 2;
        const bf16x8 b0 = *(LAS const bf16x8*)(Ks + ATT_KSWZ(r32, cb));
        const bf16x8 b1 = *(LAS const bf16x8*)(Ks + ATT_KSWZ(32 + r32, cb));
        p0 = __builtin_amdgcn_mfma_f32_32x32x16_bf16(b0, qr[d0], p0, 0, 0, 0);
        p1 = __builtin_amdgcn_mfma_f32_32x32x16_bf16(b1, qr[d0], p1, 0, 0, 0); }
}
__device__ __forceinline__ void pack_p(const f32x16& p0, const f32x16& p1, bf16x8& pa0, bf16x8& pa1, bf16x8& pa2, bf16x8& pa3) {
#define ATT_PK4(P, BASE, OUT) do { unsigned a0 = cvtpk(P[BASE + 0], P[BASE + 1]), a1 = cvtpk(P[BASE + 2], P[BASE + 3]);   \
    unsigned b0 = cvtpk(P[BASE + 4], P[BASE + 5]), b1 = cvtpk(P[BASE + 6], P[BASE + 7]);                              \
    auto r0 = __builtin_amdgcn_permlane32_swap(a0, b0, false, false); auto r1 = __builtin_amdgcn_permlane32_swap(a1, b1, false, false); \
    u32x4v w = {r0[0], r1[0], r0[1], r1[1]}; OUT = __builtin_bit_cast(bf16x8, w); } while (0)
    ATT_PK4(p0, 0, pa0); ATT_PK4(p0, 8, pa1); ATT_PK4(p1, 0, pa2); ATT_PK4(p1, 8, pa3);
#undef ATT_PK4
}
__device__ __forceinline__ float lo_hi_sum(float v) { auto rr = __builtin_amdgcn_permlane32_swap(f2u(v), f2u(v), false, false);
    return u2f(rr[0]) + u2f(rr[1]); }
__device__ __forceinline__ float lo_hi_max(float v) { auto rr = __builtin_amdgcn_permlane32_swap(f2u(v), f2u(v), false, false);
    return fmaxf(u2f(rr[0]), u2f(rr[1])); }

__device__ __forceinline__ void dsa_attn_unit(LAS unsigned char* lds, const bf16* __restrict__ U, const unsigned long long* __restrict__ MASK, bf16* __restrict__ OB, int b, int qb) {
    constexpr float SCALE = 0.088388347648318440f, C = SCALE * 1.4426950408889634f, THR = 8.f;
    int tid_ = threadIdx.x; asm volatile("" : "+v"(tid_));
    const int tid = tid_, wid = __builtin_amdgcn_readfirstlane(tid >> 6), lane = tid & 63, r32 = lane & 31, hi = lane >> 5;
    LAS float* wsc = (LAS float*)(lds + WS_OFF) + wid * 64; LAS float* li_l = wsc; LAS float* al_l = wsc + 32;
    const int NT = (qb >> 1) + 1;
    const int tq = b * SEQ + qb * 32 + wid * 4 + (r32 >> 3), head = r32 & 7;
    float m_reg = -1e30f, l_reg = 0.f; f32x16 o[4] = {}; bf16x8 qr[8];
    { const bf16* Qw = U + (size_t)tq * LDU + U_QA + head * 128 + hi * 8;
#pragma unroll
      for (int d0 = 0; d0 < 8; ++d0) qr[d0] = *(const bf16x8*)(Qw + d0 * 16); }
    const unsigned long long* mrow = MASK + (size_t)tq * 32;
    const int sr = tid >> 4, sc = (tid & 15) * 8, vst0 = v_st(sr, sc), vst1 = v_st(32 + sr, sc), kst0 = ATT_KSWZ(sr, sc * 2), kst1 = ATT_KSWZ(32 + sr, sc * 2);
    const bf16* Cb = U + (size_t)(b * SEQ) * LDU + U_CA + sc;
    const int vb0 = (int)(uintptr_t)(lds + V_OFF) + v_rd_base(lane);
    bf16x8 s0, s1;
    s0 = *(const bf16x8*)(Cb + (size_t)sr * LDU); s1 = *(const bf16x8*)(Cb + (size_t)(32 + sr) * LDU);
    unsigned long long mw = mrow[0];
    __syncthreads();
    *(LAS bf16x8*)(lds + K_OFF + kst0) = s0; *(LAS bf16x8*)(lds + K_OFF + kst1) = s1; *(LAS bf16x8*)(lds + V_OFF + vst0) = s0; *(LAS bf16x8*)(lds + V_OFF + vst1) = s1;
    __syncthreads();
    for (int j = 0; j < NT; ++j) {
        const int bo = (j & 1) * TILE_B, bn = ((j + 1) & 1) * TILE_B; const bool more = j + 1 < NT;
        unsigned long long mwn = mw;
        if (more) { s0 = *(const bf16x8*)(Cb + (size_t)((j + 1) * 64 + sr) * LDU); s1 = *(const bf16x8*)(Cb + (size_t)((j + 1) * 64 + 32 + sr) * LDU); mwn = mrow[j + 1]; }
        f32x16 p0, p1;
        qkt(p0, p1, lds + K_OFF + bo, qr, r32, hi);
        { const unsigned wlo = (unsigned)mw >> (4 * hi), whi = (unsigned)(mw >> 32) >> (4 * hi);
#pragma unroll
          for (int r = 0; r < 16; ++r) { const int bit = (r & 3) + 8 * (r >> 2);
              const unsigned m0 = (unsigned)(((int)(wlo << (31 - bit))) >> 31), m1 = (unsigned)(((int)(whi << (31 - bit))) >> 31);
              p0[r] = u2f((f2u(p0[r]) & m0) | (0xff800000u & ~m0));
              p1[r] = u2f((f2u(p1[r]) & m1) | (0xff800000u & ~m1)); } }
        float pmax = p0[0];
#pragma unroll
        for (int r = 1; r < 16; ++r) pmax = fmaxf(pmax, p0[r]);
#pragma unroll
        for (int r = 0; r < 16; ++r) pmax = fmaxf(pmax, p1[r]);
        pmax = lo_hi_max(pmax);
        float mn, alpha;
        if (__all(pmax - m_reg <= THR / SCALE)) { mn = m_reg; alpha = 1.f; }
        else { mn = fmaxf(m_reg, pmax); alpha = __builtin_amdgcn_exp2f((m_reg - mn) * C); m_reg = mn; }
        const float mnC = -mn * C;
#pragma unroll
        for (int r = 0; r < 16; ++r) { p0[r] = __builtin_amdgcn_exp2f(fmaf(p0[r], C, mnC)); p1[r] = __builtin_amdgcn_exp2f(fmaf(p1[r], C, mnC)); }
        float ps = 0.f;
#pragma unroll
        for (int r = 0; r < 16; ++r) ps += p0[r] + p1[r];
        ps = lo_hi_sum(ps);
        l_reg = l_reg * alpha + ps;
        bf16x8 pa0, pa1, pa2, pa3; pack_p(p0, p1, pa0, pa1, pa2, pa3);
        if (__any(alpha < 1.f)) { if (hi == 0) al_l[r32] = alpha; asm volatile("s_waitcnt lgkmcnt(0)" ::: "memory");
#pragma unroll
            for (int d = 0; d < 4; ++d)
#pragma unroll
                for (int r = 0; r < 16; ++r) o[d][r] *= al_l[crow(r, hi)]; }
        pv_d0(o, vb0 + bo, pa0, pa1, pa2, pa3);
        if (more) { *(LAS bf16x8*)(lds + K_OFF + bn + kst0) = s0; *(LAS bf16x8*)(lds + K_OFF + bn + kst1) = s1; *(LAS bf16x8*)(lds + V_OFF + bn + vst0) = s0; *(LAS bf16x8*)(lds + V_OFF + bn + vst1) = s1; }
        mw = mwn;
        __syncthreads();
    }
    if (hi == 0) li_l[r32] = l_reg; asm volatile("s_waitcnt lgkmcnt(0)" ::: "memory");
    bf16* Ow = OB + (size_t)(b * SEQ + qb * 32 + wid * 4) * DM;
#pragma unroll
    for (int r = 0; r < 16; ++r) { const int orow = crow(r, hi); const float rl = __builtin_amdgcn_rcpf(li_l[orow]);
        bf16* op = Ow + (size_t)(orow >> 3) * DM + (orow & 7) * 128 + r32;
#pragma unroll
        for (int d0 = 0; d0 < 4; ++d0) op[d0 * 32] = (bf16)f2bf(o[d0][r] * rl); }
}
__device__ __forceinline__ void dsa_attn_phase(Frame& F) {
    const bf16* U = (const bf16*)(F.ws + WS_BIG); const unsigned long long* MASK = (const unsigned long long*)(F.ws + WS_MASK); bf16* OB = (bf16*)(F.ws + WS_OB);
    for (int wg = F.vcu; wg < 256; wg += F.G) { const int b = wg >> 4, i = wg & 15;
#pragma unroll 1
        for (int k = 0; k < 4; ++k) { const int qb = k == 0 ? 63 - i : (k == 1 ? 32 + i : (k == 2 ? 31 - i : i)); dsa_attn_unit(F.lds, U, MASK, OB, b, qb); } }
}

__device__ __forceinline__ void sb_unit(LAS unsigned char* lds, const bf16* __restrict__ QKV, bf16* __restrict__ OB, int b, int h, int i) {
    constexpr float C = 0.088388347648318440f * 1.4426950408889634f, DONE_THR = 160.f;
    int tid_ = threadIdx.x; asm volatile("" : "+v"(tid_));
    const int tid = tid_, wid = __builtin_amdgcn_readfirstlane(tid >> 6), lane = tid & 63, r32 = lane & 31, hi = lane >> 5;
    LAS volatile unsigned* flags = (LAS volatile unsigned*)(lds + FLAG_OFF);
    const int t = 256 * i + 32 * wid + r32;
    f32x16 o[4] = {}; bf16x8 qr[8];
    { const bf16* Qw = QKV + (size_t)(b * SEQ + t) * LDQKV + h * 128 + hi * 8;
#pragma unroll
      for (int d0 = 0; d0 < 8; ++d0) qr[d0] = *(const bf16x8*)(Qw + d0 * 16); }
    const int sr = tid >> 4, sc = (tid & 15) * 8, vst0 = v_st(sr, sc), vst1 = v_st(32 + sr, sc), kst0 = ATT_KSWZ(sr, sc * 2), kst1 = ATT_KSWZ(32 + sr, sc * 2);
    const bf16* Kb = QKV + (size_t)(b * SEQ) * LDQKV + 2048 + h * 128 + sc; const bf16* Vb = Kb + 2048;
    const int vb0 = (int)(uintptr_t)(lds + V_OFF) + v_rd_base(lane);
    const float f0 = hi ? 0.f : 1.f;
    float Rneg = 0.f;
    bf16x8 k0, k1, v0, v1;
    int jt = 4 * i + 3;
    k0 = *(const bf16x8*)(Kb + (size_t)(jt * 64 + sr) * LDQKV); k1 = *(const bf16x8*)(Kb + (size_t)(jt * 64 + 32 + sr) * LDQKV);
    v0 = *(const bf16x8*)(Vb + (size_t)(jt * 64 + sr) * LDQKV); v1 = *(const bf16x8*)(Vb + (size_t)(jt * 64 + 32 + sr) * LDQKV);
    __syncthreads();
    *(LAS bf16x8*)(lds + K_OFF + kst0) = k0; *(LAS bf16x8*)(lds + K_OFF + kst1) = k1; *(LAS bf16x8*)(lds + V_OFF + vst0) = v0; *(LAS bf16x8*)(lds + V_OFF + vst1) = v1;
    __syncthreads();
    for (int it = 0; jt >= 0; ++it, --jt) {
        const int bo = (it & 1) * TILE_B, bn = ((it + 1) & 1) * TILE_B; const bool more = jt > 0;
        if (more) { const int kn = (jt - 1) * 64;
            k0 = *(const bf16x8*)(Kb + (size_t)(kn + sr) * LDQKV); k1 = *(const bf16x8*)(Kb + (size_t)(kn + 32 + sr) * LDQKV);
            v0 = *(const bf16x8*)(Vb + (size_t)(kn + sr) * LDQKV); v1 = *(const bf16x8*)(Vb + (size_t)(kn + 32 + sr) * LDQKV); }
        const bool wdone = __all(Rneg > DONE_THR);
        if (!wdone) {
            const int kbase = jt * 64 + 4 * hi - t;
            const bool diag = jt >= 4 * i;
            float run = Rneg;
            bf16x8 pa0, pa1, pa2, pa3;
#define SB_HALF(KOFF, KD0, PA, PB) do { \
            f32x16 p = {}; \
            _Pragma("unroll") for (int d0 = 0; d0 < 8; ++d0) { const int cb = (d0 * 16 + hi * 8) * 2; \
                const bf16x8 kf = *(LAS const bf16x8*)(lds + K_OFF + bo + ATT_KSWZ((KOFF) + r32, cb)); p = __builtin_amdgcn_mfma_f32_32x32x16_bf16(kf, qr[d0], p, 0, 0, 0); } \
            _Pragma("unroll") for (int r = 0; r < 16; ++r) p[r] *= C; \
            if (diag) { _Pragma("unroll") for (int r = 0; r < 16; ++r) { if (kbase + (KD0) + (r & 3) + 8 * (r >> 2) >= 0) p[r] = -1e30f; } } \
            f32x16 x; \
            _Pragma("unroll") for (int r = 0; r < 16; ++r) x[r] = fmaxf(p[r], 0.f) + __builtin_amdgcn_logf(1.0f + __builtin_amdgcn_exp2f(-__builtin_fabsf(p[r]))); \
            float Lo[4], Up[4]; \
            _Pragma("unroll") for (int g = 0; g < 4; ++g) { const float T = (x[4 * g] + x[4 * g + 1]) + (x[4 * g + 2] + x[4 * g + 3]); \
                auto rr = __builtin_amdgcn_permlane32_swap(f2u(T), f2u(T), false, false); \
                Lo[g] = u2f(rr[0]); Up[g] = u2f(rr[1]); } \
            _Pragma("unroll") for (int g = 3; g >= 0; --g) { const float off = fmaf(f0, Up[g], run); run += Up[g] + Lo[g]; \
                const float x3 = x[4 * g + 3], x2 = x[4 * g + 2], x1 = x[4 * g + 1], x0 = x[4 * g]; const float e2 = off + x3, e1 = e2 + x2, e0 = e1 + x1; \
                p[4 * g + 3] = __builtin_amdgcn_exp2f((p[4 * g + 3] - x3) - off); p[4 * g + 2] = __builtin_amdgcn_exp2f((p[4 * g + 2] - x2) - e2); \
                p[4 * g + 1] = __builtin_amdgcn_exp2f((p[4 * g + 1] - x1) - e1); p[4 * g] = __builtin_amdgcn_exp2f((p[4 * g] - x0) - e0); } \
            { unsigned a0 = cvtpk(p[0], p[1]), a1 = cvtpk(p[2], p[3]), b0 = cvtpk(p[4], p[5]), b1 = cvtpk(p[6], p[7]); \
              auto r0 = __builtin_amdgcn_permlane32_swap(a0, b0, false, false); auto r1 = __builtin_amdgcn_permlane32_swap(a1, b1, false, false); \
              u32x4v w = {r0[0], r1[0], r0[1], r1[1]}; PA = __builtin_bit_cast(bf16x8, w); } \
            { unsigned a0 = cvtpk(p[8], p[9]), a1 = cvtpk(p[10], p[11]), b0 = cvtpk(p[12], p[13]), b1 = cvtpk(p[14], p[15]); \
              auto r0 = __builtin_amdgcn_permlane32_swap(a0, b0, false, false); auto r1 = __builtin_amdgcn_permlane32_swap(a1, b1, false, false); \
              u32x4v w = {r0[0], r1[0], r0[1], r1[1]}; PB = __builtin_bit_cast(bf16x8, w); } } while (0)
            SB_HALF(32, 32, pa2, pa3);
            SB_HALF(0, 0, pa0, pa1);
#undef SB_HALF
            Rneg = run;
            pv_d0(o, vb0 + bo, pa0, pa1, pa2, pa3);
        }
        if (lane == 0) flags[(it & 1) * 8 + wid] = wdone ? 1u : 0u;
        if (more) { *(LAS bf16x8*)(lds + K_OFF + bn + kst0) = k0; *(LAS bf16x8*)(lds + K_OFF + bn + kst1) = k1; *(LAS bf16x8*)(lds + V_OFF + bn + vst0) = v0; *(LAS bf16x8*)(lds + V_OFF + bn + vst1) = v1; }
        __syncthreads();
        { unsigned a = 1u;
#pragma unroll
          for (int w = 0; w < 8; ++w) a &= flags[(it & 1) * 8 + w];
          if (a) break; }
    }
    bf16* Ow = OB + (size_t)(b * SEQ + 256 * i + 32 * wid) * DM + h * 128 + r32;
#pragma unroll
    for (int r = 0; r < 16; ++r) { const int orow = crow(r, hi);
#pragma unroll
        for (int d0 = 0; d0 < 4; ++d0) Ow[(size_t)orow * DM + d0 * 32] = (bf16)f2bf(o[d0][r]); }
}
__device__ __forceinline__ void sb_phase(Frame& F) {
    const bf16* QKV = (const bf16*)(F.ws + WS_BIG); bf16* OB = (bf16*)(F.ws + WS_OB);
    for (int wg = F.vcu; wg < 256; wg += F.G) { const int b = wg >> 4, h = wg & 15;
#pragma unroll 1
        for (int i = 7; i >= 0; --i) sb_unit(F.lds, QKV, OB, b, h, i); }
}
}
namespace idx {
constexpr int KROW = 144, STAGE_KEYS = 256, STAGE_B = STAGE_KEYS * KROW;
__device__ __forceinline__ unsigned mono(float f) { const unsigned u = __builtin_bit_cast(unsigned, f); return u ^ ((unsigned)((int)u >> 31) | 0x80000000u); }
__device__ __forceinline__ void topk_unit(LAS unsigned char* lds, const bf16* __restrict__ U, unsigned* __restrict__ MASKW, int b, int g) {
    int tid_ = threadIdx.x; asm volatile("" : "+v"(tid_));
    const int tid = tid_, wid = __builtin_amdgcn_readfirstlane(tid >> 6), lane = tid & 63, r32 = lane & 31, hi = lane >> 5;
    const int t0 = 16 * g, nk = ((t0 >> 6) + 1) << 6, ntile = nk >> 5, nstage = (nk + STAGE_KEYS - 1) / STAGE_KEYS;
    const int tok0 = b * SEQ + t0 + 2 * wid;
    bf16x8 qa[4]; float wq[16];
    { const bf16* qp = U + (size_t)(tok0 + (r32 >> 4)) * LDU + U_QI + (r32 & 15) * 64 + hi * 8;
#pragma unroll
      for (int ks = 0; ks < 4; ++ks) qa[ks] = *(const bf16x8*)(qp + ks * 16);
#pragma unroll
      for (int q = 0; q < 2; ++q)
#pragma unroll
          for (int blk = 0; blk < 2; ++blk) { const v2u w = *(const v2u*)(U + (size_t)(tok0 + q) * LDU + U_WI + 8 * blk + 4 * hi);
              wq[8 * q + 4 * blk + 0] = bflo(w.x); wq[8 * q + 4 * blk + 1] = bfhi(w.x); wq[8 * q + 4 * blk + 2] = bflo(w.y); wq[8 * q + 4 * blk + 3] = bfhi(w.y); } }
    const int skey = tid >> 1, shalf = tid & 1;
    const bf16* kg = U + (size_t)(b * SEQ + skey) * LDU + U_KI + shalf * 32;
    const int sdst = skey * KROW + shalf * 64;
    v4u st[4];
#pragma unroll
    for (int c = 0; c < 4; ++c) st[c] = *(const v4u*)(kg + c * 8);
    __syncthreads();
#pragma unroll
    for (int c = 0; c < 4; ++c) *(LAS v4u*)(lds + sdst + c * 16) = st[c];
    __syncthreads();
    unsigned sc[64];
#pragma unroll
    for (int i = 0; i < 64; ++i) sc[i] = 0u;
    const int rdo = r32 * KROW + hi * 16;
#pragma unroll
    for (int s = 0; s < 8; ++s) {
        if (s < nstage) {
            const bool more = s + 1 < nstage;
            if (more) {
#pragma unroll
                for (int c = 0; c < 4; ++c) st[c] = *(const v4u*)(kg + (size_t)(s + 1) * STAGE_KEYS * LDU + c * 8); }
            LAS const unsigned char* kb = lds + (s & 1) * STAGE_B + rdo;
#pragma unroll
            for (int tt = 0; tt < 8; ++tt) {
                const int i = s * 8 + tt;
                if (i < ntile) {
                    f32x16 acc = {};
#pragma unroll
                    for (int ks = 0; ks < 4; ++ks) { const bf16x8 kf = *(LAS const bf16x8*)(kb + tt * 32 * KROW + ks * 32); acc = __builtin_amdgcn_mfma_f32_32x32x16_bf16(qa[ks], kf, acc, 0, 0, 0); }
                    float p0 = 0.f, p1 = 0.f;
#pragma unroll
                    for (int r = 0; r < 8; ++r) { p0 = fmaf(wq[r], fmaxf(acc[r], 0.f), p0); p1 = fmaf(wq[8 + r], fmaxf(acc[8 + r], 0.f), p1); }
                    auto rr = __builtin_amdgcn_permlane32_swap(f2u(p0), f2u(p1), false, false);
                    const float sv = (u2f(rr[0]) + u2f(rr[1])) * 0.03125f;
                    sc[i] = mono(sv);
                }
            }
            if (more) {
#pragma unroll
                for (int c = 0; c < 4; ++c) *(LAS v4u*)(lds + ((s + 1) & 1) * STAGE_B + sdst + c * 16) = st[c]; }
            __syncthreads();
        }
    }
    unsigned T0 = 1u, T1 = 1u; int rem0 = 0, rem1 = 0;
    if (nk > 256) {
        unsigned tau0 = 0u, tau1 = 0u; bool d0 = false, d1 = false;
#pragma unroll 1
        for (int bit = 31; bit >= 0; --bit) {
            const unsigned c0 = tau0 | (1u << bit), c1 = tau1 | (1u << bit);
            const unsigned cand = hi ? c1 : c0;
            int n0 = 0, n1 = 0;
#pragma unroll
            for (int s = 0; s < 8; ++s) if (s < nstage) {
#pragma unroll
                for (int tt = 0; tt < 8; ++tt) { const unsigned long long m = __builtin_amdgcn_ballot_w64(sc[s * 8 + tt] >= cand); n0 += __builtin_popcount((unsigned)m); n1 += __builtin_popcount((unsigned)(m >> 32)); } }
            if (!d0 && n0 >= 256) { tau0 = c0; if (n0 == 256) d0 = true; }
            if (!d1 && n1 >= 256) { tau1 = c1; if (n1 == 256) d1 = true; }
            if (d0 && d1) break;
        }
        T0 = tau0 - 1u; T1 = tau1 - 1u;
        if (!d0 || !d1) {
            const unsigned tv = hi ? tau1 : tau0; int n0 = 0, n1 = 0;
#pragma unroll
            for (int i = 0; i < 64; ++i) { const unsigned long long m = __builtin_amdgcn_ballot_w64(sc[i] > tv); n0 += __builtin_popcount((unsigned)m); n1 += __builtin_popcount((unsigned)(m >> 32)); }
            if (!d0) { T0 = tau0; rem0 = 256 - n0; }
            if (!d1) { T1 = tau1; rem1 = 256 - n1; }
        }
    }
    const unsigned Tv = hi ? T1 : T0;
    unsigned m0 = 0u, m1 = 0u;
#pragma unroll
    for (int i = 0; i < 64; ++i) {
        const unsigned long long gt = __builtin_amdgcn_ballot_w64(sc[i] > Tv);
        unsigned w0 = (unsigned)gt, w1 = (unsigned)(gt >> 32);
        if (rem0 | rem1) {
            const unsigned long long eq = __builtin_amdgcn_ballot_w64(sc[i] == Tv);
            unsigned e0 = rem0 > 0 ? (unsigned)eq : 0u, e1 = rem1 > 0 ? (unsigned)(eq >> 32) : 0u;
            while (__builtin_popcount(e0) > rem0) e0 &= ~(0x80000000u >> __builtin_clz(e0));
            while (__builtin_popcount(e1) > rem1) e1 &= ~(0x80000000u >> __builtin_clz(e1));
            rem0 -= __builtin_popcount(e0); rem1 -= __builtin_popcount(e1); w0 |= e0; w1 |= e1;
        }
        m0 = (lane == i) ? w0 : m0; m1 = (lane == i) ? w1 : m1;
    }
    MASKW[(size_t)tok0 * 64 + lane] = m0; MASKW[(size_t)(tok0 + 1) * 64 + lane] = m1;
}
}
namespace gla {
constexpr int QE_OFF = 0, KE_OFF = 17408, KDT_OFF = 34816, ATT_OFF = 53248, O_OFF = 0, V_OFF = 66560, LR_OFF = 100352, TOT_OFF = 104448, DEC_OFF = 108544;
constexpr int QP = 272, KTP = 144, VP = 528, OP = 1040;
__device__ __forceinline__ s16x4 tr_read0(int addr) { s16x4 r; asm volatile("ds_read_b64_tr_b16 %0, %1" : "=&v"(r) : "v"(addr) : "memory"); return r; }
__device__ __forceinline__ void gla_unit(LAS unsigned char* lds, const bf16* __restrict__ U, const float* __restrict__ w_gk, const float* __restrict__ b_gk, const float* __restrict__ gnorm, bf16* __restrict__ OB, int b, int h) {
    constexpr float LOG2E = 1.4426950408889634f;
    int tid_ = threadIdx.x; asm volatile("" : "+v"(tid_));
    const int tid = tid_, wid = __builtin_amdgcn_readfirstlane(tid >> 6), lane = tid & 63, r32 = lane & 31, hi = lane >> 5;
    const int d0 = 2 * lane;
    float wg[2][16], bg[2];
#pragma unroll
    for (int r = 0; r < 16; ++r) { wg[0][r] = w_gk[r * 512 + h * 128 + d0]; wg[1][r] = w_gk[r * 512 + h * 128 + d0 + 1]; }
    bg[0] = b_gk[h * 128 + d0]; bg[1] = b_gk[h * 128 + d0 + 1];
    f32x16 S[4] = {};
    LAS float* LR = (LAS float*)(lds + LR_OFF); LAS float* TOT = (LAS float*)(lds + TOT_OFF); LAS float* DEC = (LAS float*)(lds + DEC_OFF);
    const int ldsb = (int)(uintptr_t)lds;
    const int vtr = ldsb + V_OFF + (8 * (lane >> 5) + ((lane & 15) >> 2)) * VP + (32 * wid + 16 * ((lane >> 4) & 1) + 4 * (lane & 3)) * 2;
#pragma unroll 1
    for (int n = 0; n < 32; ++n) {
        const int tok0 = b * SEQ + n * 64;
        { const int c = tid >> 3, r0 = (tid & 7) * 2; const unsigned w = *(const unsigned*)(U + (size_t)(tok0 + c) * LDU + U_LR + r0); LR[c * 16 + r0] = bflo(w); LR[c * 16 + r0 + 1] = bfhi(w); }
        { const int row = tid >> 3;
#pragma unroll
          for (int k = 0; k < 4; ++k) { const int ch = (tid & 7) + 8 * k; const v4u v = *(const v4u*)(U + (size_t)(tok0 + row) * LDU + U_VB + h * 256 + ch * 8); *(LAS v4u*)(lds + V_OFF + row * VP + ch * 16) = v; } }
        unsigned qw[8], kw[8];
#pragma unroll
        for (int j = 0; j < 8; ++j) { const bf16* up = U + (size_t)(tok0 + 8 * wid + j) * LDU + h * 128 + d0; qw[j] = *(const unsigned*)(up + U_QB); kw[j] = *(const unsigned*)(up + U_KB); }
        __syncthreads();
        float G[2][8];
#pragma unroll
        for (int j = 0; j < 8; ++j) { const int c = 8 * wid + j; float x0 = bg[0], x1 = bg[1];
#pragma unroll
            for (int r4 = 0; r4 < 4; ++r4) { const f32x4 l4 = *(LAS const f32x4*)(LR + c * 16 + 4 * r4);
#pragma unroll
                for (int e = 0; e < 4; ++e) { x0 = fmaf(l4[e], wg[0][4 * r4 + e], x0); x1 = fmaf(l4[e], wg[1][4 * r4 + e], x1); } }
            const float g0 = (fminf(x0, 0.f) * LOG2E - __builtin_amdgcn_logf(1.0f + __builtin_amdgcn_exp2f(-__builtin_fabsf(x0) * LOG2E))) * 0.0625f;
            const float g1 = (fminf(x1, 0.f) * LOG2E - __builtin_amdgcn_logf(1.0f + __builtin_amdgcn_exp2f(-__builtin_fabsf(x1) * LOG2E))) * 0.0625f;
            G[0][j] = g0 + (j ? G[0][j - 1] : 0.f); G[1][j] = g1 + (j ? G[1][j - 1] : 0.f); }
        TOT[wid * 128 + d0] = G[0][7]; TOT[wid * 128 + d0 + 1] = G[1][7];
        __syncthreads();
        float off0 = 0.f, off1 = 0.f, gl0 = 0.f, gl1 = 0.f;
#pragma unroll
        for (int w = 0; w < 8; ++w) { const f32x2 t2 = *(LAS const f32x2*)(TOT + w * 128 + d0); if (w < wid) { off0 += t2.x; off1 += t2.y; } gl0 += t2.x; gl1 += t2.y; }
#pragma unroll
        for (int j = 0; j < 8; ++j) { const int c = 8 * wid + j; const float G0 = G[0][j] + off0, G1 = G[1][j] + off1;
            const float e0 = __builtin_amdgcn_exp2f(G0), e1 = __builtin_amdgcn_exp2f(G1), i0 = __builtin_amdgcn_exp2f(-G0), i1 = __builtin_amdgcn_exp2f(-G1);
            const float x0 = __builtin_amdgcn_exp2f(gl0 - G0), x1 = __builtin_amdgcn_exp2f(gl1 - G1);
            const float q0 = bflo(qw[j]), q1 = bfhi(qw[j]), k0 = bflo(kw[j]), k1 = bfhi(kw[j]);
            *(LAS unsigned*)(lds + QE_OFF + c * QP + d0 * 2) = pk2(q0 * e0 * 0.08838834764831845f, q1 * e1 * 0.08838834764831845f);
            *(LAS unsigned*)(lds + KE_OFF + c * QP + d0 * 2) = pk2(k0 * i0, k1 * i1);
            *(LAS unsigned short*)(lds + KDT_OFF + d0 * KTP + c * 2) = (unsigned short)f2bf(k0 * x0);
            *(LAS unsigned short*)(lds + KDT_OFF + (d0 + 1) * KTP + c * 2) = (unsigned short)f2bf(k1 * x1); }
        if (wid == 0) { DEC[d0] = __builtin_amdgcn_exp2f(gl0); DEC[d0 + 1] = __builtin_amdgcn_exp2f(gl1); }
        __syncthreads();
        if (wid < 3) { const int rt = wid ? 1 : 0, ct = wid == 2 ? 1 : 0; f32x16 acc = {};
#pragma unroll
            for (int ks = 0; ks < 8; ++ks) { const bf16x8 a = *(LAS const bf16x8*)(lds + KE_OFF + (32 * ct + r32) * QP + (16 * ks + 8 * hi) * 2);
                const bf16x8 bq = *(LAS const bf16x8*)(lds + QE_OFF + (32 * rt + r32) * QP + (16 * ks + 8 * hi) * 2);
                acc = __builtin_amdgcn_mfma_f32_32x32x16_bf16(a, bq, acc, 0, 0, 0); }
            const int c = 32 * rt + r32;
#pragma unroll
            for (int q4 = 0; q4 < 4; ++q4) { const int s0 = 32 * ct + 8 * q4 + 4 * hi; float v[4];
#pragma unroll
                for (int e = 0; e < 4; ++e) v[e] = (s0 + e <= c) ? acc[4 * q4 + e] : 0.f;
                v2u w; w.x = pk2(v[0], v[1]); w.y = pk2(v[2], v[3]); *(LAS v2u*)(lds + ATT_OFF + c * KTP + s0 * 2) = w; } }
        __syncthreads();
        bf16x8 vf[4];
        { s16x4 tl[4], th[4];
#pragma unroll
          for (int ks = 0; ks < 4; ++ks) { tl[ks] = tr_read0(vtr + (16 * ks) * VP); th[ks] = tr_read0(vtr + (16 * ks + 4) * VP); }
          asm volatile("s_waitcnt lgkmcnt(0)" ::: "memory"); __builtin_amdgcn_sched_barrier(0);
#pragma unroll
          for (int ks = 0; ks < 4; ++ks) vf[ks] = (bf16x8){tl[ks][0], tl[ks][1], tl[ks][2], tl[ks][3], th[ks][0], th[ks][1], th[ks][2], th[ks][3]}; }
        f32x16 o0 = {}, o1 = {};
#pragma unroll
        for (int ks = 0; ks < 4; ++ks) { const bf16x8 a1 = *(LAS const bf16x8*)(lds + ATT_OFF + (32 + r32) * KTP + (16 * ks + 8 * hi) * 2);
            o1 = __builtin_amdgcn_mfma_f32_32x32x16_bf16(a1, vf[ks], o1, 0, 0, 0);
            if (ks < 2) { const bf16x8 a0 = *(LAS const bf16x8*)(lds + ATT_OFF + r32 * KTP + (16 * ks + 8 * hi) * 2); o0 = __builtin_amdgcn_mfma_f32_32x32x16_bf16(a0, vf[ks], o0, 0, 0, 0); } }
#pragma unroll
        for (int kb = 0; kb < 4; ++kb)
#pragma unroll
            for (int s2 = 0; s2 < 2; ++s2) {
                att::u32x4v sw; sw.x = att::cvtpk(S[kb][8 * s2 + 0], S[kb][8 * s2 + 1]); sw.y = att::cvtpk(S[kb][8 * s2 + 2], S[kb][8 * s2 + 3]);
                sw.z = att::cvtpk(S[kb][8 * s2 + 4], S[kb][8 * s2 + 5]); sw.w = att::cvtpk(S[kb][8 * s2 + 6], S[kb][8 * s2 + 7]);
                const bf16x8 sb = __builtin_bit_cast(bf16x8, sw);
                const int col = 32 * kb + 16 * s2 + 4 * hi;
                const v2u qa0 = *(LAS const v2u*)(lds + QE_OFF + r32 * QP + col * 2), qa1 = *(LAS const v2u*)(lds + QE_OFF + r32 * QP + (col + 8) * 2);
                const v2u qb0 = *(LAS const v2u*)(lds + QE_OFF + (32 + r32) * QP + col * 2), qb1 = *(LAS const v2u*)(lds + QE_OFF + (32 + r32) * QP + (col + 8) * 2);
                const att::u32x4v A0 = {qa0.x, qa0.y, qa1.x, qa1.y}, A1 = {qb0.x, qb0.y, qb1.x, qb1.y};
                o0 = __builtin_amdgcn_mfma_f32_32x32x16_bf16(__builtin_bit_cast(bf16x8, A0), sb, o0, 0, 0, 0);
                o1 = __builtin_amdgcn_mfma_f32_32x32x16_bf16(__builtin_bit_cast(bf16x8, A1), sb, o1, 0, 0, 0); }
#pragma unroll
        for (int kb = 0; kb < 4; ++kb) {
#pragma unroll
            for (int q4 = 0; q4 < 4; ++q4) { const f32x4 dc = *(LAS const f32x4*)(DEC + 32 * kb + 8 * q4 + 4 * hi);
#pragma unroll
                for (int e = 0; e < 4; ++e) S[kb][4 * q4 + e] *= dc[e]; }
#pragma unroll
            for (int ks = 0; ks < 4; ++ks) { const bf16x8 a = *(LAS const bf16x8*)(lds + KDT_OFF + (32 * kb + r32) * KTP + (16 * ks + 8 * hi) * 2);
                S[kb] = __builtin_amdgcn_mfma_f32_32x32x16_bf16(a, vf[ks], S[kb], 0, 0, 0); } }
        __syncthreads();
#pragma unroll
        for (int r = 0; r < 16; ++r) { const int c = att::crow(r, hi);
            *(LAS float*)(lds + O_OFF + c * OP + (32 * wid + r32) * 4) = o0[r]; *(LAS float*)(lds + O_OFF + (32 + c) * OP + (32 * wid + r32) * 4) = o1[r]; }
        __syncthreads();
        { const int c = tid >> 3, seg = tid & 7; f32x4 ov[8]; float ss = 0.f;
#pragma unroll
          for (int k = 0; k < 8; ++k) { ov[k] = *(LAS const f32x4*)(lds + O_OFF + c * OP + (32 * seg + 4 * k) * 4); ss += (ov[k].x * ov[k].x + ov[k].y * ov[k].y) + (ov[k].z * ov[k].z + ov[k].w * ov[k].w); }
          ss += __shfl_xor(ss, 1); ss += __shfl_xor(ss, 2); ss += __shfl_xor(ss, 4);
          const float rs = 1.0f / sqrtf(ss * (1.0f / 256.0f) + EPS);
          const bf16* gp = U + (size_t)(tok0 + c) * LDU + U_GB + h * 256 + 32 * seg; bf16* op = OB + (size_t)(tok0 + c) * DM + 1024 + h * 256 + 32 * seg;
#pragma unroll
          for (int k2 = 0; k2 < 4; ++k2) { const v4u gw = *(const v4u*)(gp + 8 * k2); const f32x4 n0 = *(const f32x4*)(gnorm + 32 * seg + 8 * k2), n1 = *(const f32x4*)(gnorm + 32 * seg + 8 * k2 + 4);
              float gv[8] = {bflo(gw.x), bfhi(gw.x), bflo(gw.y), bfhi(gw.y), bflo(gw.z), bfhi(gw.z), bflo(gw.w), bfhi(gw.w)};
              float xv[8] = {ov[2 * k2].x * n0.x, ov[2 * k2].y * n0.y, ov[2 * k2].z * n0.z, ov[2 * k2].w * n0.w, ov[2 * k2 + 1].x * n1.x, ov[2 * k2 + 1].y * n1.y, ov[2 * k2 + 1].z * n1.z, ov[2 * k2 + 1].w * n1.w};
              float rv[8];
#pragma unroll
              for (int e = 0; e < 8; ++e) { const float sg = gv[e] * __builtin_amdgcn_rcpf(1.0f + __builtin_amdgcn_exp2f(-gv[e] * LOG2E)); rv[e] = xv[e] * rs * sg; }
              v4u w; w.x = pk2(rv[0], rv[1]); w.y = pk2(rv[2], rv[3]); w.z = pk2(rv[4], rv[5]); w.w = pk2(rv[6], rv[7]); *(v4u*)(op + 8 * k2) = w; } }
        __syncthreads();
    }
}
}
#ifndef MK_ONE_LAUNCH
#define MK_ONE_LAUNCH 1
#endif
#ifndef MK_NAIVE_DSA
#define MK_NAIVE_DSA 0
#endif
#ifndef MK_DSA_MODE
#define MK_DSA_MODE 0
#endif
#ifndef MK_NAIVE_GLA
#define MK_NAIVE_GLA 0
#endif
#ifndef MK_NAIVE_SB
#define MK_NAIVE_SB 0
#endif
constexpr int N_PHASES = 20;
struct Args { const float* in[19]; float* out; unsigned char* ws; int ph_lo, ph_hi; };
static_assert(sizeof(Args) == 19 * 8 + 8 + 8 + 8, "Args has no padding");

__global__ void __launch_bounds__(NWAVES * 64, 2) mk_fwd(Args args) {
    extern __shared__ __attribute__((aligned(16))) unsigned char lds[];
    Frame F;
    F.lds = (LAS unsigned char*)lds;
    F.MISC = (volatile LAS unsigned*)(F.lds + MISC_OFF);
    F.tid = threadIdx.x; F.lane = F.tid & 63; F.wave = __builtin_amdgcn_readfirstlane(F.tid >> 6);
    F.G = gridDim.x; { const int bx = blockIdx.x; F.vcu = (F.G % 8 == 0) ? (bx % 8) * (F.G / 8) + bx / 8 : bx; }
    unsigned char* ws = args.ws; F.ws = ws; F.out = args.out;
    F.ctl = (gu32*)(ws + WS_CTL);
#pragma unroll
    for (int i = 0; i < 19; ++i) F.in[i] = args.in[i];
    for (int u = F.tid; u < (LDS_BYTES - LDSCTL_OFF) / 4; u += NWAVES * 64) ((LAS unsigned*)(F.lds + LDSCTL_OFF))[u] = 0u;
    __syncthreads();
    XcdBarrier bar; bar.bar = (unsigned*)(F.ctl + CW_BAR); bar.x = 0; bar.st = nullptr;
    if (MK_ONE_LAUNCH) bar = xcd_barrier_post((unsigned*)(F.ctl + CW_BAR), F.MISC + 8);
#define GRID_BAR() do { if (MK_ONE_LAUNCH) xcd_barrier(bar); } while (0)
    const int lo = args.ph_lo, hi = args.ph_hi;
#define IN(k) (lo <= (k) && (k) < hi)
#define BOTH(k) (IN(k) && IN((k) + 1))
    bf16* HB = (bf16*)(ws + WS_HB); float* RS = (float*)(ws + WS_RSTD); bf16* BIG = (bf16*)(ws + WS_BIG); bf16* OB = (bf16*)(ws + WS_OB); bf16* PB = (bf16*)(ws + WS_PB);
    const int bx = (int)blockIdx.x;

    if (IN(0)) { p0_prologue(F); if (BOTH(0)) GRID_BAR(); }
    if (IN(1)) {
        pg8::Gemm g{HB, (const bf16*)(ws + WS_WIN0), MT, LDU, DM}; pg8::StaticOrder S; S.init(MT, LDU, F.G, bx);
        pg8::EpiScaleBf16 E{BIG, LDU, RS};
        pg8::gemm_phase<pg8::EpiScaleBf16, pg8::StaticOrder, true, true>(F.lds + RING_OFF, g, S, E);
        if (BOTH(1)) GRID_BAR();
    }
    if (IN(2)) {
#if !MK_NAIVE_GLA
        if (bx < 64) gla::gla_unit(F.lds, BIG, F.in[4], F.in[5], F.in[6], OB, bx >> 2, bx & 3);
#endif
#if !MK_NAIVE_DSA && (MK_DSA_MODE == 0 || MK_DSA_MODE == 3)
        for (;;) {
            __syncthreads(); if (F.tid == 0) F.MISC[0] = __hip_atomic_fetch_add((unsigned*)(F.ctl + CW_Q), 1u, __ATOMIC_RELAXED, __HIP_MEMORY_SCOPE_AGENT); __syncthreads();
            const int q = (int)F.MISC[0]; if (q >= 2048) break;
            const int c = 31 - (q >> 6), rem = q & 63;
            idx::topk_unit(F.lds, BIG, (unsigned*)(ws + WS_MASK), rem >> 2, 4 * c + (rem & 3));
        }
#endif
        if (BOTH(2)) GRID_BAR();
    }
    if (IN(3)) {
#if !MK_NAIVE_DSA && (MK_DSA_MODE == 0 || MK_DSA_MODE == 2)
        att::dsa_attn_phase(F);
#endif
        if (BOTH(3)) GRID_BAR();
    }
    if (IN(4)) {
        pg8::Gemm g{OB, (const bf16*)(ws + WS_WOUT0), MT, DM, DM}; pg8::StaticOrder S; S.init(MT, DM, F.G, bx);
        pg8::EpiRes E{F.in[0], F.out, DM};
        pg8::gemm_phase<pg8::EpiRes, pg8::StaticOrder, true, true>(F.lds + RING_OFF, g, S, E);
        if (BOTH(4)) GRID_BAR();
    }
#pragma unroll
    for (int l = 0; l < 2; ++l) {
        const int pb = 5 + 9 * l;
        if (l == 1) {
            if (IN(11)) {
                pg8::Gemm g{HB, (const bf16*)(ws + WS_WIN1), MT, LDQKV, DM}; pg8::StaticOrder S; S.init(MT, LDQKV, F.G, bx);
                pg8::EpiScaleBf16 E{BIG, LDQKV, RS};
                pg8::gemm_phase<pg8::EpiScaleBf16, pg8::StaticOrder, true, true>(F.lds + RING_OFF, g, S, E);
                if (BOTH(11)) GRID_BAR();
            }
            if (IN(12)) {
#if !MK_NAIVE_SB
                att::sb_phase(F);
#endif
                if (BOTH(12)) GRID_BAR();
            }
            if (IN(13)) {
                pg8::Gemm g{OB, (const bf16*)(ws + WS_WOUT1), MT, DM, DM}; pg8::StaticOrder S; S.init(MT, DM, F.G, bx);
                pg8::EpiRes E{F.out, F.out, DM};
                pg8::gemm_phase<pg8::EpiRes, pg8::StaticOrder, true, true>(F.lds + RING_OFF, g, S, E);
                if (BOTH(13)) GRID_BAR();
            }
        }
        if (IN(pb)) { norm_phase(F, F.out); if (BOTH(pb)) GRID_BAR(); }
        if (IN(pb + 1)) {
            pg8::Gemm g{HB, (const bf16*)(ws + WS_WGU + (size_t)l * 44 * MiB), MT, 2 * FF, DM}; pg8::StaticOrder S; S.init(MT, 2 * FF, F.G, bx);
            pg8::EpiSwiglu E{BIG, FF, RS};
            pg8::gemm_phase<pg8::EpiSwiglu, pg8::StaticOrder, true, true>(F.lds + RING_OFF, g, S, E);
            if (BOTH(pb + 1)) GRID_BAR();
        }
        if (IN(pb + 2)) {
            { pg8::Gemm g{BIG, (const bf16*)(ws + WS_WD + (size_t)l * 22 * MiB), MT, DM, FF}; pg8::StaticOrder S; S.init(MT, DM, F.G, bx);
              pg8::EpiRes E{F.out, F.out, DM};
              pg8::gemm_phase<pg8::EpiRes, pg8::StaticOrder, true, true>(F.lds + RING_OFF, g, S, E); }
            { pg8::Gemm g{PB + (size_t)l * MT * PLE, (const bf16*)(ws + WS_WPE + (size_t)l * 1 * MiB), MT, DM, PLE}; pg8::StaticOrder S; S.init(MT, DM, F.G, bx);
              pg8::EpiScaleBf16 E{OB, DM, nullptr};
              pg8::gemm_phase<pg8::EpiScaleBf16, pg8::StaticOrder, true, true>(F.lds + RING_OFF, g, S, E); }
            if (BOTH(pb + 2)) GRID_BAR();
        }
        if (IN(pb + 3)) { norm_phase(F, F.out); if (BOTH(pb + 3)) GRID_BAR(); }
        if (IN(pb + 4)) {
            pg8::Gemm g{HB, (const bf16*)(ws + WS_WPG + (size_t)l * 8 * MiB), MT, DM, DM}; pg8::StaticOrder S; S.init(MT, DM, F.G, bx);
            pg8::EpiPle E{F.out, OB, DM, RS};
            pg8::gemm_phase<pg8::EpiPle, pg8::StaticOrder, true, true>(F.lds + RING_OFF, g, S, E);
            if (BOTH(pb + 4)) GRID_BAR();
        }
        if (IN(pb + 5)) { if (l == 0) norm_phase(F, F.out); else final_norm_phase(F); if (BOTH(pb + 5)) GRID_BAR(); }
    }
#undef IN
#undef BOTH
}

extern "C" void kernel_launch(void* const* d_in, const int* in_sizes, int n_in, void* d_out, int out_size, void* d_ws, size_t ws_size, hipStream_t stream) {
    static int grid = 0;
    if (grid == 0) {
        if (n_in != 19 || in_sizes[0] != MT * DM || out_size != MT * DM || ws_size < WS_END) { fprintf(stderr, "kernel_launch: shape/workspace mismatch (n_in %d, ws %zu < %zu)\n", n_in, ws_size, (size_t)WS_END); grid = -1; return; }
        int dev = 0, cus = 0;
        if (hipGetDevice(&dev) != hipSuccess || hipDeviceGetAttribute(&cus, hipDeviceAttributeMultiprocessorCount, dev) != hipSuccess) { grid = -1; return; }
        if (hipFuncSetAttribute((const void*)mk_fwd, hipFuncAttributeMaxDynamicSharedMemorySize, LDS_BYTES) != hipSuccess) { fprintf(stderr, "kernel_launch: hipFuncSetAttribute failed\n"); grid = -1; return; }
        int per_cu = 0;
        if (hipOccupancyMaxActiveBlocksPerMultiprocessor(&per_cu, (const void*)mk_fwd, NWAVES * 64, LDS_BYTES) != hipSuccess || per_cu < 1) { fprintf(stderr, "kernel_launch: occupancy query says %d\n", per_cu); }
        (void)hipGetLastError();
        grid = cus;
    }
    if (grid < 0) return;
    hipMemsetAsync((char*)d_ws + WS_CTL, 0, CTL_ZERO_BYTES, stream);
    Args a{};
    for (int i = 0; i < 19; ++i) a.in[i] = (const float*)d_in[i];
    a.out = (float*)d_out; a.ws = (unsigned char*)d_ws;
    unsigned char* ws = (unsigned char*)d_ws;
    const bf16* BIG = (const bf16*)(ws + WS_BIG); bf16* OB = (bf16*)(ws + WS_OB); float* ORAW = (float*)(ws + WS_ORAW);
#if MK_ONE_LAUNCH
    a.ph_lo = 0; a.ph_hi = N_PHASES;
    hipLaunchKernelGGL(mk_fwd, dim3(grid), dim3(NWAVES * 64), LDS_BYTES, stream, a);
#else
    for (int p = 0; p < N_PHASES; ++p) {
        if (p == 2 && MK_NAIVE_GLA) {
            hipLaunchKernelGGL(naive_gla, dim3(256), dim3(256), 0, stream, BIG, (const float*)d_in[4], (const float*)d_in[5], ORAW);
            hipLaunchKernelGGL(naive_gla_norm, dim3(MT * 4 / 4), dim3(256), 0, stream, (const float*)ORAW, BIG, (const float*)d_in[6], OB);
        }
        if (p == 3 && (MK_NAIVE_DSA || MK_DSA_MODE == 2)) hipLaunchKernelGGL(naive_dsa, dim3(MT), dim3(256), 0, stream, BIG, OB, (unsigned*)(ws + WS_MASK), 0);
        if (p == 4 && !MK_NAIVE_DSA && MK_DSA_MODE == 3) hipLaunchKernelGGL(naive_dsa, dim3(MT), dim3(256), 0, stream, BIG, OB, (unsigned*)(ws + WS_MASK), 1);
        if (p == 12 && MK_NAIVE_SB) hipLaunchKernelGGL(naive_sb, dim3(NB * 16 * SEQ / 4), dim3(256), 0, stream, BIG, OB);
        a.ph_lo = p; a.ph_hi = p + 1;
        hipLaunchKernelGGL(mk_fwd, dim3(grid), dim3(NWAVES * 64), LDS_BYTES, stream, a);
    }
#endif
    const hipError_t le = hipPeekAtLastError();
    if (le != hipSuccess) fprintf(stderr, "kernel_launch: launch failed: %s\n", hipGetErrorName(le));
}
```

```cpp
#include <hip/hip_runtime.h>
#include <cstdio>
#include <cstdint>

#ifndef MK_GLA_PROF
#define MK_GLA_PROF 0
#endif
#ifndef MK_IDX_PROF
#define MK_IDX_PROF 0
#endif
#ifndef MK_GEMM_RELAX
#define MK_GEMM_RELAX 1
#endif
#ifndef MK_CLK_PROBE
#define MK_CLK_PROBE 0
#endif
#ifndef MK_GEMM_PROF
#define MK_GEMM_PROF 0
#endif
#ifndef MK_SB_PROF
#define MK_SB_PROF 0
#define MK_SB_SEL 0
#endif
constexpr int NB = 16, SEQ = 2048, DM = 2048, MT = NB * SEQ;
constexpr int PLE = 256, FF = 5632;
constexpr int EVEN_IN = 5344, LDU = 5376;
constexpr int U_QA = 0, U_CA = 1024, U_QI = 1152, U_KI = 2176, U_WI = 2240, U_QB = 2256, U_KB = 2768, U_VB = 3280, U_GB = 4304, U_LR = 5328;
constexpr int LDQKV = 6144;
constexpr float EPS = 1e-6f;
constexpr int NWAVES = 8;

constexpr size_t MiB = 1u << 20;
constexpr size_t WS_CTL = 0, CTL_ZERO_BYTES = 1 * MiB;
constexpr size_t WS_WIN0 = 1 * MiB;
constexpr size_t WS_WOUT0 = WS_WIN0 + 21 * MiB;
constexpr size_t WS_WIN1 = WS_WOUT0 + 8 * MiB;
constexpr size_t WS_WOUT1 = WS_WIN1 + 24 * MiB;
constexpr size_t WS_WGU = WS_WOUT1 + 8 * MiB;
constexpr size_t WS_WD = WS_WGU + 88 * MiB;
constexpr size_t WS_WPG = WS_WD + 44 * MiB;
constexpr size_t WS_WPE = WS_WPG + 16 * MiB;
constexpr size_t WS_SSQA = WS_WPE + 2 * MiB;
constexpr size_t WS_SSQB = WS_SSQA + 4 * MiB;
constexpr size_t WS_HB = WS_SSQB + 4 * MiB;
constexpr size_t WS_PB = WS_HB + 128 * MiB;
constexpr size_t WS_BIG = WS_PB + 32 * MiB;
constexpr size_t WS_OB = WS_BIG + 384 * MiB;
constexpr size_t WS_MASK = WS_OB + 128 * MiB;
constexpr size_t WS_END = WS_MASK + 8 * MiB;
static_assert(WS_END <= 1024 * MiB, "workspace map must fit 4 x 256 MiB");

constexpr int CW_TMO = 0, CW_CODE = 1, CW_BAR = 4096, CW_Q = 8192, CW_FLG_REL = 64;

constexpr int RING_OFF = 0, RING_BYTES = 151552;
constexpr int LDSCTL_OFF = RING_BYTES, MISC_OFF = LDSCTL_OFF + 320;
constexpr int LDS_BYTES = 155648;

#define GAS __attribute__((address_space(1)))
#define LAS __attribute__((address_space(3)))
typedef unsigned short bf16;
typedef unsigned v4u __attribute__((ext_vector_type(4)));
typedef unsigned v2u __attribute__((ext_vector_type(2)));
typedef float f32x4 __attribute__((ext_vector_type(4)));
typedef float f32x2 __attribute__((ext_vector_type(2)));
typedef float f32x16 __attribute__((ext_vector_type(16)));
typedef short bf16x8 __attribute__((ext_vector_type(8)));
typedef short s16x4 __attribute__((ext_vector_type(4)));
typedef GAS unsigned gu32;
#define RLX_AGENT __ATOMIC_RELAXED, __HIP_MEMORY_SCOPE_AGENT
#define LDS_WAIT() asm volatile("s_waitcnt lgkmcnt(0)" ::: "memory")
#define VM_WAIT() asm volatile("s_waitcnt vmcnt(0)" ::: "memory")
__device__ __forceinline__ unsigned f2bf(float f) { unsigned u = __builtin_bit_cast(unsigned, f); return (u + 0x7fffu + ((u >> 16) & 1u)) >> 16; }
__device__ __forceinline__ unsigned pk2(float lo, float hi) { return f2bf(lo) | (f2bf(hi) << 16); }
__device__ __forceinline__ float bf2f(unsigned short b) { return __builtin_bit_cast(float, ((unsigned)b) << 16); }
__device__ __forceinline__ float bflo(unsigned w) { return __builtin_bit_cast(float, w << 16); }
__device__ __forceinline__ float bfhi(unsigned w) { return __builtin_bit_cast(float, w & 0xffff0000u); }
__device__ __forceinline__ float u2f(unsigned u) { return __builtin_bit_cast(float, u); }
__device__ __forceinline__ unsigned f2u(float f) { return __builtin_bit_cast(unsigned, f); }
namespace pg8 {
#define PG8_LAS __attribute__((address_space(3)))
typedef unsigned short bf16_t;
typedef short bf16x8 __attribute__((ext_vector_type(8)));
typedef float f32x4 __attribute__((ext_vector_type(4)));
typedef unsigned u32x4 __attribute__((ext_vector_type(4)));
constexpr int BM = 256, BK = 64, HALF = 128, HTB = HALF * BK * 2  , STAGE_BYTES = 8 * HTB, NXCD = 8, WGM = 8;

__host__ __device__ __forceinline__ int lds_byte(int r, int c) { const int st = (r >> 4) * 2 + (c >> 5), rr = r & 15, cc = c & 31, ob = rr * 64 + cc * 2; return st * 1024 + (ob ^ (((ob >> 9) & 1) << 5)); }
__host__ __device__ __forceinline__ void stage_rc(int b, int& R, int& C) { const int st = b / 1024, sb = b % 1024, swz = sb ^ (((sb >> 9) & 1) << 5); R = (st >> 1) * 16 + swz / 64; C = (st & 1) * 32 + (swz % 64) / 2; }
__host__ __device__ __forceinline__ int perm32(int rho) { const int n = rho >> 4, i = rho & 15; return 8 * (i >> 2) + 4 * n + (i & 3); }

struct Unit { int pm, pn; };
struct Gemm { const bf16_t* A; const bf16_t* Bt; int M, N, K; };

struct StaticOrder {
    int nM, nN, nwg, G, c;
    __host__ __device__ void init(int M, int N, int G_, int c_) { nM = M / BM; nN = N / BM; nwg = nM * nN; G = G_; c = c_; }
    __host__ __device__ bool next(int i, Unit& u) const {
        const long L = (long)i * G + c; if (L >= nwg) return false;
        int wgid = (int)L; { const int q = nwg / NXCD, r = nwg % NXCD, xcd = wgid % NXCD, off = wgid / NXCD; wgid = (xcd < r ? xcd * (q + 1) : r * (q + 1) + (xcd - r) * q) + off; }
        const int wgm = (nN == 8) ? 4 : WGM;
        const int nig = wgm * nN, gid = wgid / nig, fm = gid * wgm, gsz = (nM - fm) < wgm ? (nM - fm) : wgm;
        u.pm = fm + ((wgid % nig) % gsz); u.pn = (wgid % nig) / gsz; return true;
    }
    __device__ __forceinline__ void a_ready(const Unit&) const {}
    __device__ __forceinline__ void done(const Unit&) const {}
};

__device__ __forceinline__ unsigned cvt_pk_bf16(float lo, float hi) { unsigned r; asm volatile("v_cvt_pk_bf16_f32 %0, %1, %2" : "=v"(r) : "v"(lo), "v"(hi)); return r; }
__device__ __forceinline__ void rows_rstd(float (&rs)[2][4], const float* __restrict__ ssq, int row0, int fq) {
#pragma unroll
    for (int ai = 0; ai < 2; ++ai) {
        f32x4 a[4], b[4];
#pragma unroll
        for (int m = 0; m < 4; ++m) { const float* p = ssq + (size_t)(row0 + ai * HALF + m * 16) * 32 + fq * 8; a[m] = *(const f32x4*)p; b[m] = *(const f32x4*)(p + 4); }
#pragma unroll
        for (int m = 0; m < 4; ++m) { float s = ((a[m][0] + a[m][1]) + (a[m][2] + a[m][3])) + ((b[m][0] + b[m][1]) + (b[m][2] + b[m][3]));
            s += __shfl_xor(s, 16); s += __shfl_xor(s, 32); rs[ai][m] = __builtin_amdgcn_rsqf(s * (1.0f / 2048.0f) + 1e-6f); }
        asm volatile("" ::: "memory");
    }
}
struct RstdCache { int* tag; PG8_LAS float* slot; };
__device__ __forceinline__ void rows_rstd_cached(float (&rs)[2][4], const float* __restrict__ ssq, int row0, int fq, int pm, const RstdCache& c, int lane) {
    PG8_LAS f32x4* p = (PG8_LAS f32x4*)(c.slot + lane * 8);
    if (*c.tag == pm) { const f32x4 a = p[0], b = p[1]; rs[0][0] = a[0]; rs[0][1] = a[1]; rs[0][2] = a[2]; rs[0][3] = a[3]; rs[1][0] = b[0]; rs[1][1] = b[1]; rs[1][2] = b[2]; rs[1][3] = b[3]; }
    else { rows_rstd(rs, ssq, row0, fq); p[0] = (f32x4){rs[0][0], rs[0][1], rs[0][2], rs[0][3]}; p[1] = (f32x4){rs[1][0], rs[1][1], rs[1][2], rs[1][3]}; *c.tag = pm; }
}
struct EpiScaleBf16 {
    static constexpr bool PERM = true, AFTER_DRAIN = false, INIT_ACC = false; static constexpr int NST = 16;
    bf16_t* O; int ldc; const float* ssq; RstdCache rc; int silu_lo, silu_hi;
    __device__ __forceinline__ void operator()(const f32x4 (&acc)[2][2][4][2], const Unit& u, int wr, int wc, int fr, int fq) const {
        const int row0 = u.pm * BM + wr * 64 + fr, col0 = u.pn * BM + wc * 32 + 8 * fq;
        float rs[2][4];
        if (ssq) rows_rstd_cached(rs, ssq, row0, fq, u.pm, rc, fq * 16 + fr);
        else {
#pragma unroll
            for (int ai = 0; ai < 2; ++ai)
#pragma unroll
                for (int m = 0; m < 4; ++m) rs[ai][m] = 1.f; }
        const bool tile_gated = u.pn * BM < silu_hi && u.pn * BM + BM > silu_lo;
#pragma unroll
        for (int ai = 0; ai < 2; ++ai)
#pragma unroll
            for (int m = 0; m < 4; ++m) { const int row = row0 + ai * HALF + m * 16; const float r1 = rs[ai][m]; bf16_t* rowp = O + (size_t)row * ldc + col0;
#pragma unroll
                for (int bj = 0; bj < 2; ++bj) { f32x4 v0 = acc[ai][bj][m][0] * r1, v1 = acc[ai][bj][m][1] * r1;
                    if (tile_gated) { const int c = col0 + bj * HALF; const bool g = c >= silu_lo && c < silu_hi;
#pragma unroll
                        for (int j = 0; j < 4; ++j) { const float a = v0[j], b = v1[j];
                            const float sa = a * __builtin_amdgcn_rcpf(1.0f + __builtin_amdgcn_exp2f(a * -1.4426950408889634f)), sb = b * __builtin_amdgcn_rcpf(1.0f + __builtin_amdgcn_exp2f(b * -1.4426950408889634f));
                            v0[j] = g ? sa : a; v1[j] = g ? sb : b; } }
                    u32x4 w; w.x = cvt_pk_bf16(v0[0], v0[1]); w.y = cvt_pk_bf16(v0[2], v0[3]); w.z = cvt_pk_bf16(v1[0], v1[1]); w.w = cvt_pk_bf16(v1[2], v1[3]);
                    *(u32x4*)(rowp + bj * HALF) = w; } }
    }
};
struct EpiSwiglu {
    static constexpr bool PERM = true, AFTER_DRAIN = false, INIT_ACC = false; static constexpr int NST = 8;
    bf16_t* O; int ldc; const float* ssq; RstdCache rc;
    __device__ __forceinline__ void operator()(const f32x4 (&acc)[2][2][4][2], const Unit& u, int wr, int wc, int fr, int fq) const {
        const int row0 = u.pm * BM + wr * 64 + fr, col0 = u.pn * HALF + wc * 32 + 8 * fq;
        float rs[2][4]; rows_rstd_cached(rs, ssq, row0, fq, u.pm, rc, fq * 16 + fr);
#pragma unroll
        for (int ai = 0; ai < 2; ++ai)
#pragma unroll
            for (int m = 0; m < 4; ++m) { const int row = row0 + ai * HALF + m * 16; const float r1 = rs[ai][m]; bf16_t* rowp = O + (size_t)row * ldc + col0;
                float h[8];
#pragma unroll
                for (int n = 0; n < 2; ++n)
#pragma unroll
                    for (int j = 0; j < 4; ++j) { const float g = acc[ai][0][m][n][j] * r1, up = acc[ai][1][m][n][j] * r1;
                        const float e = __builtin_amdgcn_exp2f(g * -1.4426950408889634f); h[n * 4 + j] = g * __builtin_amdgcn_rcpf(1.0f + e) * up; }
                u32x4 w; w.x = cvt_pk_bf16(h[0], h[1]); w.y = cvt_pk_bf16(h[2], h[3]); w.z = cvt_pk_bf16(h[4], h[5]); w.w = cvt_pk_bf16(h[6], h[7]);
                *(u32x4*)rowp = w; }
    }
};
__device__ __forceinline__ void unpack8(float (&o)[8], const u32x4 q) {
    const unsigned a = q.x, b = q.y, c = q.z, d = q.w;
    o[0] = __builtin_bit_cast(float, a << 16); o[1] = __builtin_bit_cast(float, a & 0xffff0000u); o[2] = __builtin_bit_cast(float, b << 16); o[3] = __builtin_bit_cast(float, b & 0xffff0000u);
    o[4] = __builtin_bit_cast(float, c << 16); o[5] = __builtin_bit_cast(float, c & 0xffff0000u); o[6] = __builtin_bit_cast(float, d << 16); o[7] = __builtin_bit_cast(float, d & 0xffff0000u);
}
struct EpiRes {
    static constexpr bool PERM = true, AFTER_DRAIN = false, INIT_ACC = false; static constexpr int NST = 16;
    const bf16_t* base; bf16_t* hb; int ldc; float* ssq_out;
    __device__ __forceinline__ void operator()(const f32x4 (&acc)[2][2][4][2], const Unit& u, int wr, int wc, int fr, int fq) const {
        const int row0 = u.pm * BM + wr * 64 + fr, col0 = u.pn * BM + wc * 32 + 8 * fq;
#pragma unroll
        for (int ai = 0; ai < 2; ++ai) {
            u32x4 bs[4][2];
#pragma unroll
            for (int m = 0; m < 4; ++m)
#pragma unroll
                for (int bj = 0; bj < 2; ++bj) bs[m][bj] = *(const u32x4*)(base + (size_t)(row0 + ai * HALF + m * 16) * ldc + col0 + bj * HALF);
            asm volatile("" ::: "memory");
#pragma unroll
            for (int m = 0; m < 4; ++m) { const int row = row0 + ai * HALF + m * 16; const size_t off = (size_t)row * ldc + col0; float ss = 0.f;
#pragma unroll
                for (int bj = 0; bj < 2; ++bj) { float o[8]; unpack8(o, bs[m][bj]);
#pragma unroll
                    for (int j = 0; j < 4; ++j) { o[j] += acc[ai][bj][m][0][j]; o[4 + j] += acc[ai][bj][m][1][j]; }
#pragma unroll
                    for (int j = 0; j < 8; ++j) ss += o[j] * o[j];
                    u32x4 w; w.x = cvt_pk_bf16(o[0], o[1]); w.y = cvt_pk_bf16(o[2], o[3]); w.z = cvt_pk_bf16(o[4], o[5]); w.w = cvt_pk_bf16(o[6], o[7]); *(u32x4*)(hb + off + bj * HALF) = w; }
                ss += __shfl_xor(ss, 16); ss += __shfl_xor(ss, 32);
                if (fq == 0) ssq_out[(size_t)row * 32 + u.pn * 4 + wc] = ss; }
            asm volatile("" ::: "memory");
        }
    }
};
struct EpiPle {
    static constexpr bool PERM = true, AFTER_DRAIN = false, INIT_ACC = false; static constexpr int NST = 16;
    const bf16_t* h; bf16_t* pe; int ldc; const float* ssq; float* ssq_out; RstdCache rc;
    __device__ __forceinline__ void operator()(const f32x4 (&acc)[2][2][4][2], const Unit& u, int wr, int wc, int fr, int fq) const {
        const int row0 = u.pm * BM + wr * 64 + fr, col0 = u.pn * BM + wc * 32 + 8 * fq;
        float rs[2][4]; rows_rstd_cached(rs, ssq, row0, fq, u.pm, rc, fq * 16 + fr);
        asm volatile("" ::: "memory");
#pragma unroll
        for (int ai = 0; ai < 2; ++ai) {
            u32x4 hq[4][2], pq[4][2];
#pragma unroll
            for (int m = 0; m < 4; ++m)
#pragma unroll
                for (int bj = 0; bj < 2; ++bj) { const size_t o2 = (size_t)(row0 + ai * HALF + m * 16) * ldc + col0 + bj * HALF; hq[m][bj] = *(const u32x4*)(h + o2); pq[m][bj] = *(const u32x4*)(pe + o2); }
            asm volatile("" ::: "memory");
#pragma unroll
            for (int m = 0; m < 4; ++m) { const int row = row0 + ai * HALF + m * 16; const float r1 = rs[ai][m]; float ss = 0.f;
#pragma unroll
                for (int bj = 0; bj < 2; ++bj) { float hv[8], pv[8], o[8]; unpack8(hv, hq[m][bj]); unpack8(pv, pq[m][bj]);
#pragma unroll
                    for (int j = 0; j < 8; ++j) { const float a = acc[ai][bj][m][j >> 2][j & 3] * r1; const float e2 = __builtin_amdgcn_exp2f(a * -1.4426950408889634f); o[j] = hv[j] + pv[j] * __builtin_amdgcn_rcpf(1.0f + e2); ss += o[j] * o[j]; }
                    u32x4 w; w.x = cvt_pk_bf16(o[0], o[1]); w.y = cvt_pk_bf16(o[2], o[3]); w.z = cvt_pk_bf16(o[4], o[5]); w.w = cvt_pk_bf16(o[6], o[7]); *(u32x4*)(pe + (size_t)row * ldc + col0 + bj * HALF) = w; }
                ss += __shfl_xor(ss, 16); ss += __shfl_xor(ss, 32);
                if (fq == 0) ssq_out[(size_t)row * 32 + u.pn * 4 + wc] = ss; }
            asm volatile("" ::: "memory");
        }
    }
};
template <class Epi, class Sched, bool ALIGN_EPI = false, bool SP2 = false>
__device__ __forceinline__ void gemm_phase(PG8_LAS unsigned char* lds, const Gemm g, const Sched& S, const Epi& E) {
    int tid_ = threadIdx.x; asm volatile("" : "+v"(tid_));
    const int tid = tid_, wid = __builtin_amdgcn_readfirstlane(tid >> 6), lane = tid & 63, wr = wid >> 2, wc = wid & 3, fr = lane & 15, fq = lane >> 4;
    const int K = g.K, nt = K / BK;
    unsigned voffA[2], voffB[2];
#pragma unroll
    for (int i = 0; i < 2; ++i) { int R, C; stage_rc(tid * 16 + i * 8192, R, C); const int Rb = Epi::PERM ? ((R & ~31) + perm32(R & 31)) : R;
        voffA[i] = (unsigned)(R * K + C) * 2u; voffB[i] = (unsigned)(Rb * K + C) * 2u; }
    const size_t kstep = (size_t)(BK * 2);
    const size_t hstep = (size_t)HALF * K * 2;
    const size_t tstep = 2 * hstep;
    const unsigned ldsw = (unsigned)wid * 1024u;
    const int aoff = lds_byte(wr * 64 + fr, fq * 8), boff = lds_byte(wc * 32 + fr, fq * 8);
#define PG8_SA(b, h) (((b) * 2 + (h)) * HTB)
#define PG8_SB(b, h) ((4 + (b) * 2 + (h)) * HTB)
#define PG8_STAGE(bufoff, gbase, voff) do { _Pragma("unroll") for (int _i = 0; _i < 2; ++_i) \
        __builtin_amdgcn_global_load_lds((const unsigned*)((const char*)(gbase) + (voff)[_i]), (PG8_LAS unsigned*)(lds + (bufoff) + ldsw + _i * 8192), 16, 0, 0); } while (0)
#define PG8_LDA(dst, b, h) do { _Pragma("unroll") for (int m = 0; m < 4; ++m) _Pragma("unroll") for (int k = 0; k < 2; ++k) dst[m][k] = *(const PG8_LAS bf16x8*)(lds + PG8_SA(b, h) + aoff + m * 2048 + k * 1024); } while (0)
#define PG8_LDB(dst, b, h) do { _Pragma("unroll") for (int n = 0; n < 2; ++n) _Pragma("unroll") for (int k = 0; k < 2; ++k) dst[n][k] = *(const PG8_LAS bf16x8*)(lds + PG8_SB(b, h) + boff + n * 2048 + k * 1024); } while (0)
#define PG8_MMA(ai, bj, At, Bt) do { __builtin_amdgcn_s_setprio(1); _Pragma("unroll") for (int m = 0; m < 4; ++m) _Pragma("unroll") for (int n = 0; n < 2; ++n) _Pragma("unroll") for (int k = 0; k < 2; ++k) \
        acc[ai][bj][m][n] = __builtin_amdgcn_mfma_f32_16x16x32_bf16(Bt[n][k], At[m][k], acc[ai][bj][m][n], 0, 0, 0); __builtin_amdgcn_s_setprio(0); } while (0)
#define PG8_WAIT_V(n) asm volatile("s_waitcnt vmcnt(" #n ")" ::: "memory")
#define PG8_WAIT_L(n) asm volatile("s_waitcnt lgkmcnt(" #n ")" ::: "memory")
#define PG8_BAR __builtin_amdgcn_s_barrier()
#define PG8_SCHED __builtin_amdgcn_sched_barrier(0)
    Unit cur, nxt; int ui = 0;
    if (!S.next(0, cur)) return;
    f32x4 acc[2][2][4][2];
    if constexpr (Epi::INIT_ACC) E.init(acc, cur, wr, wc, fr, fq);
    else {
#pragma unroll
    for (int a = 0; a < 2; ++a)
#pragma unroll
        for (int b = 0; b < 2; ++b)
#pragma unroll
            for (int m = 0; m < 4; ++m)
#pragma unroll
                for (int n = 0; n < 2; ++n) acc[a][b][m][n] = (f32x4){0.f, 0.f, 0.f, 0.f};
    }
    bf16x8 At[4][2], B0[2][2], B1[2][2];
    const char* cA = (const char*)g.A + (size_t)cur.pm * tstep; const char* cB = (const char*)g.Bt + (size_t)cur.pn * tstep;
    S.a_ready(cur);
    if constexpr (SP2) {
        PG8_STAGE(PG8_SB(0, 0), cB, voffB); PG8_STAGE(PG8_SB(0, 1), cB + hstep, voffB); PG8_STAGE(PG8_SA(0, 0), cA, voffA); PG8_STAGE(PG8_SA(0, 1), cA + hstep, voffA);
        if (wr == 1) PG8_BAR;
        PG8_WAIT_V(2); PG8_BAR;
        PG8_STAGE(PG8_SB(1, 0), cB + kstep, voffB); PG8_STAGE(PG8_SA(1, 0), cA + kstep, voffA); PG8_STAGE(PG8_SB(1, 1), cB + hstep + kstep, voffB);
        PG8_WAIT_V(6); PG8_BAR;
    } else {
        PG8_STAGE(PG8_SB(0, 0), cB, voffB); PG8_STAGE(PG8_SA(0, 0), cA, voffA); PG8_STAGE(PG8_SB(0, 1), cB + hstep, voffB); PG8_STAGE(PG8_SA(0, 1), cA + hstep, voffA);
        if (wr == 1) PG8_BAR;
        PG8_WAIT_V(4); PG8_BAR;
        PG8_STAGE(PG8_SB(1, 0), cB + kstep, voffB); PG8_STAGE(PG8_SA(1, 0), cA + kstep, voffA); PG8_STAGE(PG8_SB(1, 1), cB + hstep + kstep, voffB);
        PG8_WAIT_V(6); PG8_BAR;
    }
#if MK_GEMM_PROF
    unsigned long long gp_t = __builtin_amdgcn_s_memrealtime();
#define GP_ACC(k) do { if (tid == 0) { const unsigned long long t1_ = __builtin_amdgcn_s_memrealtime(); ((volatile PG8_LAS unsigned*)(lds + MISC_OFF))[k] += (unsigned)(t1_ - gp_t); gp_t = t1_; } } while (0)
#else
#define GP_ACC(k) do { } while (0)
#endif
    GP_ACC(22);
    for (;;) {
        const bool has_next = S.next(ui + 1, nxt);
        const char* nA = has_next ? (const char*)g.A + (size_t)nxt.pm * tstep : cA; const char* nB = has_next ? (const char*)g.Bt + (size_t)nxt.pn * tstep : cB;
        for (int t = 0; t < nt; t += 2) {
            const bool last = (t == nt - 2);
            const char* a1 = cA + (size_t)(t + 1) * kstep;
            const char* a2 = last ? nA : cA + (size_t)(t + 2) * kstep; const char* b2 = last ? nB : cB + (size_t)(t + 2) * kstep;
            const char* a3 = a2 + kstep; const char* b3 = b2 + kstep;
            if (last && has_next) S.a_ready(nxt);
            if constexpr (SP2) {
            PG8_LDB(B0, 0, 0); PG8_LDB(B1, 0, 1); PG8_SCHED; PG8_LDA(At, 0, 0); PG8_STAGE(PG8_SA(1, 1), a1 + hstep, voffA);
            PG8_WAIT_V(8); PG8_WAIT_L(0); PG8_BAR; PG8_MMA(0, 0, At, B0); PG8_MMA(0, 1, At, B1); PG8_BAR; PG8_SCHED;
            PG8_LDA(At, 0, 1); PG8_STAGE(PG8_SB(0, 0), b2, voffB); PG8_STAGE(PG8_SB(0, 1), b2 + hstep, voffB); PG8_STAGE(PG8_SA(0, 0), a2, voffA);
            PG8_WAIT_V(8); PG8_WAIT_L(0); PG8_BAR; PG8_MMA(1, 0, At, B0); PG8_MMA(1, 1, At, B1); PG8_BAR; PG8_SCHED;
            PG8_LDB(B0, 1, 0); PG8_LDB(B1, 1, 1); PG8_SCHED; PG8_LDA(At, 1, 0); PG8_STAGE(PG8_SA(0, 1), a2 + hstep, voffA);
            PG8_WAIT_V(8); PG8_WAIT_L(0); PG8_BAR; PG8_MMA(0, 0, At, B0); PG8_MMA(0, 1, At, B1); PG8_BAR; PG8_SCHED;
            PG8_LDA(At, 1, 1); PG8_STAGE(PG8_SB(1, 0), b3, voffB); PG8_STAGE(PG8_SB(1, 1), b3 + hstep, voffB); PG8_STAGE(PG8_SA(1, 0), a3, voffA);
            PG8_WAIT_V(8); PG8_WAIT_L(0); PG8_BAR; PG8_MMA(1, 0, At, B0); PG8_MMA(1, 1, At, B1); PG8_BAR; PG8_SCHED;
            } else {
            PG8_LDB(B0, 0, 0); PG8_SCHED; PG8_LDA(At, 0, 0); PG8_STAGE(PG8_SA(1, 1), a1 + hstep, voffA);
            PG8_WAIT_L(8); PG8_BAR; PG8_WAIT_L(0); PG8_MMA(0, 0, At, B0); PG8_BAR; PG8_SCHED;
            PG8_LDB(B1, 0, 1); PG8_STAGE(PG8_SB(0, 0), b2, voffB);
            PG8_BAR; PG8_WAIT_L(0); PG8_MMA(0, 1, At, B1); PG8_BAR;
            PG8_LDA(At, 0, 1); PG8_STAGE(PG8_SA(0, 0), a2, voffA);
            PG8_BAR; PG8_WAIT_L(0); PG8_MMA(1, 0, At, B0); PG8_BAR; PG8_SCHED;
            PG8_STAGE(PG8_SB(0, 1), b2 + hstep, voffB);
            PG8_WAIT_V(6); PG8_BAR; PG8_MMA(1, 1, At, B1); PG8_BAR;
            PG8_LDB(B0, 1, 0); PG8_SCHED; PG8_LDA(At, 1, 0); PG8_STAGE(PG8_SA(0, 1), a2 + hstep, voffA);
            PG8_WAIT_L(8); PG8_BAR; PG8_WAIT_L(0); PG8_MMA(0, 0, At, B0); PG8_BAR; PG8_SCHED;
            PG8_LDB(B1, 1, 1); PG8_STAGE(PG8_SB(1, 0), b3, voffB);
            PG8_BAR; PG8_WAIT_L(0); PG8_MMA(0, 1, At, B1); PG8_BAR;
            PG8_LDA(At, 1, 1); PG8_STAGE(PG8_SA(1, 0), a3, voffA);
            PG8_BAR; PG8_WAIT_L(0); PG8_MMA(1, 0, At, B0); PG8_BAR; PG8_SCHED;
            PG8_STAGE(PG8_SB(1, 1), b3 + hstep, voffB);
            PG8_WAIT_V(6); PG8_BAR; PG8_MMA(1, 1, At, B1); PG8_BAR;
            }
        }
        GP_ACC(20);
        if constexpr (ALIGN_EPI) { if (wr == 0) PG8_BAR; }
        if constexpr (!Epi::AFTER_DRAIN) { int fr_ = fr, fq_ = fq; asm volatile("" : "+v"(fr_), "+v"(fq_));
            E(acc, cur, wr, wc, fr_, fq_); S.done(cur); }
        GP_ACC(21);
        if (!has_next) break;
        if constexpr (Epi::INIT_ACC) E.init(acc, nxt, wr, wc, fr, fq);
        else {
#pragma unroll
        for (int a = 0; a < 2; ++a)
#pragma unroll
            for (int b = 0; b < 2; ++b)
#pragma unroll
                for (int m = 0; m < 4; ++m)
#pragma unroll
                    for (int n = 0; n < 2; ++n) acc[a][b][m][n] = (f32x4){0.f, 0.f, 0.f, 0.f};
        }
        cur = nxt; cA = nA; cB = nB; ++ui;
        if constexpr (ALIGN_EPI) { if (wr == 1) PG8_BAR; }
    }
    PG8_WAIT_V(0);
    if constexpr (!ALIGN_EPI) { if (wr == 0) PG8_BAR; }
    PG8_BAR;
    if constexpr (Epi::AFTER_DRAIN) { E.fused(acc, cur, wr, wc, fr, fq, lds, wid, lane); S.done(cur); }
#undef GP_ACC
#undef PG8_SA
#undef PG8_SB
#undef PG8_STAGE
#undef PG8_LDA
#undef PG8_LDB
#undef PG8_MMA
#undef PG8_WAIT_V
#undef PG8_WAIT_L
#undef PG8_BAR
#undef PG8_SCHED
}
}
#define XB_TMO      128
#define XB_XCNT(j)  (256  + 64 * (j))
#define XB_XSUB(j)  (1280 + 64 * (j))
#define XB_XGEN(j)  (2304 + 64 * (j))
#define XB_TOP      3328
#define XB_TOPGEN   3392
#define XCD_BAR_WORDS 3456
#define XB_SPIN_CAP (1u << 18)

__device__ __forceinline__ unsigned xb_ld(unsigned* p)              { return __hip_atomic_load(p, __ATOMIC_RELAXED, __HIP_MEMORY_SCOPE_AGENT); }
__device__ __forceinline__ unsigned xb_add(unsigned* p, unsigned v) { return __hip_atomic_fetch_add(p, v, __ATOMIC_RELAXED, __HIP_MEMORY_SCOPE_AGENT); }
__device__ __forceinline__ unsigned xb_xcc_id() { return (unsigned)__builtin_amdgcn_s_getreg((3 << 11) | 20) & 0xFu; }
#define XB_SPIN(cond, bar) do { unsigned _sp = 0; while (cond) { __builtin_amdgcn_s_sleep(1); \
    if ((++_sp & 255u) == 0u) { if (xb_ld(&(bar)[XB_TMO])) break; if (_sp > XB_SPIN_CAP) { atomicAdd(&(bar)[XB_TMO], 1u); break; } } } } while (0)

struct XcdBarrier {
    unsigned* bar; unsigned x;
    volatile LAS unsigned* st;
};

__device__ __forceinline__ XcdBarrier xcd_barrier_post(unsigned* bar, volatile LAS unsigned* st) {
    XcdBarrier b; b.bar = bar; b.x = xb_xcc_id(); b.st = st;
    if (threadIdx.x == 0) (void)xb_add(&bar[XB_XCNT(b.x)], 1u);
    return b;
}
__device__ __forceinline__ void xcd_barrier_complete(unsigned* bar, unsigned x, unsigned& nloc, unsigned& nx) {
    const unsigned G = gridDim.x * gridDim.y * gridDim.z;
    unsigned sum, cnt, mine, sp = 0u;
    for (;;) {
        sum = 0u; cnt = 0u; mine = 0u;
#pragma unroll
        for (unsigned j = 0; j < 16; ++j) { const unsigned c = xb_ld(&bar[XB_XCNT(j)]); sum += c; cnt += (c > 0u) ? 1u : 0u; mine = (j == x) ? c : mine; }
        if (sum == G) break;
        __builtin_amdgcn_s_sleep(1);
        if ((++sp & 255u) == 0u) { if (xb_ld(&bar[XB_TMO])) break; if (sp > XB_SPIN_CAP) { atomicAdd(&bar[XB_TMO], 1u); break; } }
    }
    nloc = mine > 0u ? mine : 1u; nx = cnt > 0u ? cnt : 1u;
}

__device__ __forceinline__ void xcd_barrier(const XcdBarrier& b) {
    asm volatile("s_waitcnt vmcnt(0)" ::: "memory");
    __syncthreads();
    if (threadIdx.x == 0) {
        unsigned* bar = b.bar;
        __builtin_amdgcn_s_waitcnt(0);
        unsigned nloc = b.st[0], nx = b.st[1];
        if (nloc == 0u) { xcd_barrier_complete(bar, b.x, nloc, nx); b.st[0] = nloc; b.st[1] = nx; }
        const unsigned old = xb_add(&bar[XB_XSUB(b.x)], 1u);
        const unsigned gen = old / nloc;
        if (old + 1u == (gen + 1u) * nloc) {
            __builtin_amdgcn_fence(__ATOMIC_RELEASE, "agent");
            asm volatile("s_waitcnt vmcnt(0)" ::: "memory");
            const unsigned og = xb_add(&bar[XB_TOP], 1u);
            const unsigned tg = og / nx;
            if (og + 1u == (tg + 1u) * nx) xb_add(&bar[XB_TOPGEN], 1u);
            else XB_SPIN(xb_ld(&bar[XB_TOPGEN]) == tg, bar);
            __builtin_amdgcn_fence(__ATOMIC_ACQUIRE, "agent");
            xb_add(&bar[XB_XGEN(b.x)], 1u);
            asm volatile("s_waitcnt vmcnt(0)" ::: "memory");
        } else {
            XB_SPIN(xb_ld(&bar[XB_XGEN(b.x)]) == gen, bar);
            __builtin_amdgcn_fence(__ATOMIC_ACQUIRE, "agent");
            asm volatile("s_waitcnt vmcnt(0)" ::: "memory");
        }
    }
    __syncthreads();
}
struct Frame {
    LAS unsigned char* lds;
    volatile LAS unsigned* MISC;
    gu32* ctl;
    int tid, lane, wave, vcu, G;
    const float* in[19]; float* out; unsigned char* ws;
};
__device__ __forceinline__ float wave_sum(float v) {
#pragma unroll
    for (int o = 1; o < 64; o <<= 1) v += __shfl_xor(v, o);
    return v;
}
__device__ __forceinline__ void p0_item(const float* W, int ldw, int k0, int n0, const float* gain, bf16* WT, int ldk, int drow0, LAS float* scr, int lane) {
    f32x4 v[8]; float gk[8];
#pragma unroll
    for (int i = 0; i < 8; ++i) { const int kk = 8 * i + (lane >> 3); v[i] = __builtin_nontemporal_load((const GAS f32x4*)(W + (size_t)(k0 + kk) * ldw + n0 + 4 * (lane & 7))); gk[i] = gain ? gain[k0 + kk] : 1.f; }
#pragma unroll
    for (int i = 0; i < 8; ++i) { const int kk = 8 * i + (lane >> 3); LAS float* d = scr + kk * 33 + 4 * (lane & 7); d[0] = v[i].x * gk[i]; d[1] = v[i].y * gk[i]; d[2] = v[i].z * gk[i]; d[3] = v[i].w * gk[i]; }
    LDS_WAIT(); asm volatile("" ::: "memory");
    const int c = lane & 7;
#pragma unroll
    for (int j = 0; j < 4; ++j) { const int n = (lane >> 3) + 8 * j; const LAS float* s = scr + (8 * c) * 33 + n;
        v4u o; o.x = pk2(s[0 * 33], s[1 * 33]); o.y = pk2(s[2 * 33], s[3 * 33]); o.z = pk2(s[4 * 33], s[5 * 33]); o.w = pk2(s[6 * 33], s[7 * 33]);
        *(GAS v4u*)(WT + (size_t)(drow0 + n) * ldk + k0 + 8 * c) = o; }
    LDS_WAIT(); asm volatile("" ::: "memory");
}
__device__ __forceinline__ void p0_matrix_item(const float* W, int K, int N, const float* gain, bf16* WT, int mode, int item, LAS float* scr, int lane) {
    const int nblk = N / 32, kb = item / nblk, nb = item % nblk, n0 = 32 * nb;
    const int drow0 = mode == 0 ? n0 : (256 * (n0 >> 7) + (n0 & 127) + (mode == 2 ? 128 : 0));
    p0_item(W, N, 64 * kb, n0, gain, WT, K, drow0, scr, lane);
}
__device__ __forceinline__ void norm_row(Frame& F, const float* xrow, bf16* orow, float* ssq_row) {
    const GAS f32x4* xr = (const GAS f32x4*)xrow + F.lane;
    f32x4 v[8]; float s = 0.f;
#pragma unroll
    for (int j = 0; j < 8; ++j) { v[j] = __builtin_nontemporal_load(xr + 64 * j); s += (v[j].x * v[j].x + v[j].y * v[j].y) + (v[j].z * v[j].z + v[j].w * v[j].w); }
    s = wave_sum(s);
    if (F.lane < 32) ssq_row[F.lane] = F.lane == 0 ? s : 0.f;
    GAS v2u* o8 = (GAS v2u*)orow + F.lane;
#pragma unroll
    for (int j = 0; j < 8; ++j) { v2u w; w.x = pk2(v[j].x, v[j].y); w.y = pk2(v[j].z, v[j].w); o8[64 * j] = w; }
}
__device__ __forceinline__ void norm_phase(Frame& F, const float* h) {
    const int gw = F.vcu * NWAVES + F.wave, NGW = F.G * NWAVES;
    bf16* HB = (bf16*)(F.ws + WS_HB); float* SQ = (float*)(F.ws + WS_SSQA);
    for (int m = gw; m < MT; m += NGW) norm_row(F, h + (size_t)m * DM, HB + (size_t)m * DM, SQ + (size_t)m * 32);
}
__device__ __forceinline__ void final_norm_phase(Frame& F) {
    int tid_ = threadIdx.x; asm volatile("" : "+v"(tid_)); const int lane = tid_ & 63;
    const int gw = F.vcu * NWAVES + F.wave, NGW = F.G * NWAVES;
    const float* g = F.in[18]; const float* SQB = (const float*)(F.ws + WS_SSQB); const bf16* HBp = (const bf16*)(F.ws + WS_HB);
    f32x4 gv[8];
#pragma unroll
    for (int j = 0; j < 4; ++j) { gv[2 * j] = *(const GAS f32x4*)(g + 512 * j + 8 * lane); gv[2 * j + 1] = *(const GAS f32x4*)(g + 512 * j + 8 * lane + 4); }
    for (int m = gw; m < MT; m += NGW) {
        v4u hw[4];
#pragma unroll
        for (int j = 0; j < 4; ++j) hw[j] = *(const GAS v4u*)(HBp + (size_t)m * DM + 512 * j + 8 * lane);
        const float s = wave_sum(lane < 32 ? SQB[(size_t)m * 32 + lane] : 0.f);
        const float rs = __builtin_amdgcn_rsqf(s * (1.f / DM) + EPS);
        GAS f32x4* orow = (GAS f32x4*)(F.out + (size_t)m * DM);
#pragma unroll
        for (int j = 0; j < 4; ++j) { const v4u q = hw[j];
            f32x4 a = {bflo(q.x), bfhi(q.x), bflo(q.y), bfhi(q.y)}, b2 = {bflo(q.z), bfhi(q.z), bflo(q.w), bfhi(q.w)};
            orow[128 * j + 2 * lane] = a * rs * gv[2 * j]; orow[128 * j + 2 * lane + 1] = b2 * rs * gv[2 * j + 1]; }
    }
}
template <int PART> __device__ __forceinline__ void p0_prologue(Frame& F) {
    int tid_ = threadIdx.x; asm volatile("" : "+v"(tid_)); const int ptid = tid_, plane = tid_ & 63;
    LAS float* scr = (LAS float*)(F.lds + RING_OFF + F.wave * 16384);
    const int gw = F.vcu * NWAVES + F.wave, NGW = F.G * NWAVES;
    unsigned char* ws = F.ws;
    constexpr int I_IN0 = (DM / 64) * (EVEN_IN / 32), I_SQ = (DM / 64) * (DM / 32), I_IN1 = (DM / 64) * (LDQKV / 32), I_GU = (DM / 64) * (FF / 32), I_D = (FF / 64) * (DM / 32), I_PE = (PLE / 64) * (DM / 32);
    constexpr int PERL = 2 * I_GU + I_D + I_SQ + I_PE, I_IN = PART ? I_IN1 : I_IN0, NITEMS = I_IN + I_SQ + PERL, l = PART;
    for (int it = gw; it < NITEMS; it += NGW) {
        int r = it;
        if (r < I_IN) { if (PART == 0) p0_matrix_item(F.in[3], DM, EVEN_IN, F.in[2], (bf16*)(ws + WS_WIN0), 0, r, scr, plane); else p0_matrix_item(F.in[9], DM, LDQKV, F.in[8], (bf16*)(ws + WS_WIN1), 0, r, scr, plane); continue; } r -= I_IN;
        if (r < I_SQ) { p0_matrix_item(F.in[PART ? 10 : 7], DM, DM, nullptr, (bf16*)(ws + (PART ? WS_WOUT1 : WS_WOUT0)), 0, r, scr, plane); continue; } r -= I_SQ;
        if (r < I_GU) { p0_matrix_item(F.in[12] + (size_t)l * DM * FF, DM, FF, F.in[11] + l * DM, (bf16*)(ws + WS_WGU + (size_t)l * 44 * MiB), 1, r, scr, plane); continue; } r -= I_GU;
        if (r < I_GU) { p0_matrix_item(F.in[13] + (size_t)l * DM * FF, DM, FF, F.in[11] + l * DM, (bf16*)(ws + WS_WGU + (size_t)l * 44 * MiB), 2, r, scr, plane); continue; } r -= I_GU;
        if (r < I_D) { p0_matrix_item(F.in[14] + (size_t)l * FF * DM, FF, DM, nullptr, (bf16*)(ws + WS_WD + (size_t)l * 22 * MiB), 0, r, scr, plane); continue; } r -= I_D;
        if (r < I_SQ) { p0_matrix_item(F.in[16] + (size_t)l * DM * DM, DM, DM, F.in[15] + l * DM, (bf16*)(ws + WS_WPG + (size_t)l * 8 * MiB), 0, r, scr, plane); continue; } r -= I_SQ;
        p0_matrix_item(F.in[17] + (size_t)l * PLE * DM, PLE, DM, nullptr, (bf16*)(ws + WS_WPE + (size_t)l * 1 * MiB), 0, r, scr, plane);
    }
    { const GAS f32x4* ps = (const GAS f32x4*)(F.in[1] + (size_t)PART * MT * PLE); GAS v4u* pd = (GAS v4u*)(ws + WS_PB + (size_t)PART * MT * PLE * 2); const size_t n8 = (size_t)MT * PLE / 8;
      for (size_t i = (size_t)F.vcu * 512 + ptid; i < n8; i += (size_t)F.G * 512) { const f32x4 a = __builtin_nontemporal_load(ps + 2 * i), b = __builtin_nontemporal_load(ps + 2 * i + 1);
          v4u o; o.x = pk2(a.x, a.y); o.y = pk2(a.z, a.w); o.z = pk2(b.x, b.y); o.w = pk2(b.z, b.w); pd[i] = o; } }
    if (PART == 0) {
        { GAS v4u* z = (GAS v4u*)(ws + WS_WIN0 + (size_t)EVEN_IN * DM * 2); const int n16 = 32 * DM * 2 / 16;
          for (int i = F.vcu * 512 + ptid; i < n16; i += F.G * 512) z[i] = (v4u){0u, 0u, 0u, 0u}; }
        norm_phase(F, F.in[0]);
    }
}
namespace att {
typedef unsigned u32x4v __attribute__((ext_vector_type(4)));
constexpr int TILE_B = 64 * 128 * 2;
constexpr int NSLOT = 4, K_OFF = 0, V_OFF = NSLOT * TILE_B, WS_OFF = 2 * NSLOT * TILE_B;
#define ATT_BAR() do { asm volatile("s_waitcnt lgkmcnt(0)" ::: "memory"); __builtin_amdgcn_s_barrier(); asm volatile("" ::: "memory"); } while (0)
constexpr int FLAG_OFF = WS_OFF + 8 * 64 * 4;
#define ATT_KSWZ(row, colB) ((row) * 256 + ((colB) ^ (((row) & 7) << 4)))
#define ATT_SBAR() __builtin_amdgcn_sched_barrier(0)
__device__ __forceinline__ int crow(int r, int hi) { return (r & 3) + 8 * (r >> 2) + 4 * hi; }
__device__ __forceinline__ unsigned cvtpk(float lo, float hi) { unsigned r; asm volatile("v_cvt_pk_bf16_f32 %0, %1, %2" : "=v"(r) : "v"(lo), "v"(hi)); return r; }
__device__ __forceinline__ int v_st(int k, int c) { const int kk = (k & ~0xC) | ((k & 4) << 1) | ((k & 8) >> 1); return ((kk >> 3) * 4 + (c >> 5)) * 512 + ((kk & 7) * 32 + (c & 31)) * 2; }
__device__ __forceinline__ int v_rd_base(int lane) { return ((lane & 3) << 3) | (((lane >> 2) & 3) << 6) | (((lane >> 4) & 1) << 5) | (((lane >> 5) & 1) << 8); }
constexpr int v_rd_off(int d0, int ks, int half) { return d0 * 512 + ks * 4096 + half * 2048; }
template <int OFF> __device__ __forceinline__ s16x4 tr_read(int vb) { s16x4 r; asm volatile("ds_read_b64_tr_b16 %0, %1 offset:%2" : "=&v"(r) : "v"(vb), "i"(OFF) : "memory"); return r; }
template <int D0> __device__ __forceinline__ void pv_one(f32x16& od, int vb, bf16x8 pa0, bf16x8 pa1, bf16x8 pa2, bf16x8 pa3) {
    const s16x4 l0 = tr_read<v_rd_off(D0, 0, 0)>(vb), h0 = tr_read<v_rd_off(D0, 0, 1)>(vb), l1 = tr_read<v_rd_off(D0, 1, 0)>(vb), h1 = tr_read<v_rd_off(D0, 1, 1)>(vb);
    const s16x4 l2 = tr_read<v_rd_off(D0, 2, 0)>(vb), h2 = tr_read<v_rd_off(D0, 2, 1)>(vb), l3 = tr_read<v_rd_off(D0, 3, 0)>(vb), h3 = tr_read<v_rd_off(D0, 3, 1)>(vb);
    asm volatile("s_waitcnt lgkmcnt(0)" ::: "memory"); ATT_SBAR();
#define ATT_PK(L, H) (bf16x8){L[0], L[1], L[2], L[3], H[0], H[1], H[2], H[3]}
    od = __builtin_amdgcn_mfma_f32_32x32x16_bf16(pa0, ATT_PK(l0, h0), od, 0, 0, 0);
    od = __builtin_amdgcn_mfma_f32_32x32x16_bf16(pa1, ATT_PK(l1, h1), od, 0, 0, 0);
    od = __builtin_amdgcn_mfma_f32_32x32x16_bf16(pa2, ATT_PK(l2, h2), od, 0, 0, 0);
    od = __builtin_amdgcn_mfma_f32_32x32x16_bf16(pa3, ATT_PK(l3, h3), od, 0, 0, 0);
#undef ATT_PK
}
__device__ __forceinline__ void pv_d0(f32x16* o, int vb, bf16x8 pa0, bf16x8 pa1, bf16x8 pa2, bf16x8 pa3) {
    pv_one<0>(o[0], vb, pa0, pa1, pa2, pa3); pv_one<1>(o[1], vb, pa0, pa1, pa2, pa3); pv_one<2>(o[2], vb, pa0, pa1, pa2, pa3); pv_one<3>(o[3], vb, pa0, pa1, pa2, pa3);
}
__device__ __forceinline__ void qkt(f32x16& p0, f32x16& p1, LAS const unsigned char* Ks, const bf16x8* qr, int r32, int hi) {
    p0 = f32x16{}; p1 = f32x16{};
#pragma unroll
    for (int d0 = 0; d0 < 8; ++d0) { const int cb = (d0 * 16 + hi * 8) * 2;
        const bf16x8 b0 = *(LAS const bf16x8*)(Ks + ATT_KSWZ(r32, cb));
        const bf16x8 b1 = *(LAS const bf16x8*)(Ks + ATT_KSWZ(32 + r32, cb));
        p0 = __builtin_amdgcn_mfma_f32_32x32x16_bf16(b0, qr[d0], p0, 0, 0, 0);
        p1 = __builtin_amdgcn_mfma_f32_32x32x16_bf16(b1, qr[d0], p1, 0, 0, 0); }
}
__device__ __forceinline__ void pack_p(const f32x16& p0, const f32x16& p1, bf16x8& pa0, bf16x8& pa1, bf16x8& pa2, bf16x8& pa3) {
#define ATT_PK4(P, BASE, OUT) do { unsigned a0 = cvtpk(P[BASE + 0], P[BASE + 1]), a1 = cvtpk(P[BASE + 2], P[BASE + 3]);   \
    unsigned b0 = cvtpk(P[BASE + 4], P[BASE + 5]), b1 = cvtpk(P[BASE + 6], P[BASE + 7]);                              \
    auto r0 = __builtin_amdgcn_permlane32_swap(a0, b0, false, false); auto r1 = __builtin_amdgcn_permlane32_swap(a1, b1, false, false); \
    u32x4v w = {r0[0], r1[0], r0[1], r1[1]}; OUT = __builtin_bit_cast(bf16x8, w); } while (0)
    ATT_PK4(p0, 0, pa0); ATT_PK4(p0, 8, pa1); ATT_PK4(p1, 0, pa2); ATT_PK4(p1, 8, pa3);
#undef ATT_PK4
}
__device__ __forceinline__ float lo_hi_sum(float v) { auto rr = __builtin_amdgcn_permlane32_swap(f2u(v), f2u(v), false, false);
    return u2f(rr[0]) + u2f(rr[1]); }
__device__ __forceinline__ float lo_hi_max(float v) { auto rr = __builtin_amdgcn_permlane32_swap(f2u(v), f2u(v), false, false);
    return fmaxf(u2f(rr[0]), u2f(rr[1])); }


__device__ __forceinline__ void dma_tile(LAS unsigned char* lds, int slot, const bf16* Kg, const bf16* Vg, int ld, int wid, int lane) {
#pragma unroll
    for (int e = 0; e < 2; ++e) { const int kk = 2 * wid + e;
        const int row = 4 * kk + (lane >> 4), ch = (lane & 15) ^ (row & 7);
        __builtin_amdgcn_global_load_lds((const unsigned*)(Kg + (size_t)row * ld + ch * 8), (LAS unsigned*)(lds + K_OFF + slot * TILE_B + kk * 1024), 16, 0, 0);
        const int st = 2 * kk + (lane >> 5), kx = 8 * (st >> 2) + ((lane & 31) >> 2), key = (kx & ~0xC) | ((kx & 4) << 1) | ((kx & 8) >> 1), col = 32 * (st & 3) + 8 * (lane & 3);
        __builtin_amdgcn_global_load_lds((const unsigned*)(Vg + (size_t)key * ld + col), (LAS unsigned*)(lds + V_OFF + slot * TILE_B + kk * 1024), 16, 0, 0); }
}

__device__ __forceinline__ void dsa_attn_unit(LAS unsigned char* lds, const bf16* __restrict__ U, const unsigned long long* __restrict__ MASK, bf16* __restrict__ OB, int b, int qb) {
    constexpr float SCALE = 0.088388347648318440f, C = SCALE * 1.4426950408889634f, THR = 8.f;
    int tid_ = threadIdx.x; asm volatile("" : "+v"(tid_));
    const int tid = tid_, wid = __builtin_amdgcn_readfirstlane(tid >> 6), lane = tid & 63, r32 = lane & 31, hi = lane >> 5;
    LAS float* wsc = (LAS float*)(lds + WS_OFF) + wid * 64; LAS float* li_l = wsc; LAS float* al_l = wsc + 32;
    const int NT = (qb >> 1) + 1;
    const int tq = b * SEQ + qb * 32 + wid * 4 + (r32 >> 3), head = r32 & 7;
    float m_reg = -1e30f, l_reg = 0.f; f32x16 o[4] = {}; bf16x8 qr[8];
    { const bf16* Qw = U + (size_t)tq * LDU + U_QA + head * 128 + hi * 8;
#pragma unroll
      for (int d0 = 0; d0 < 8; ++d0) qr[d0] = *(const bf16x8*)(Qw + d0 * 16); }
    const unsigned long long* mrow = MASK + (size_t)tq * 32;
    const bf16* Cb = U + (size_t)(b * SEQ) * LDU + U_CA;
    const int vb0 = (int)(uintptr_t)(lds + V_OFF) + v_rd_base(lane);
    unsigned long long mw = mrow[0], mw1 = mrow[NT > 1 ? 1 : 0];
    if (wid >= 4) __builtin_amdgcn_s_setprio(1);
    __syncthreads();
    dma_tile(lds, 0, Cb, Cb, LDU, wid, lane);
    dma_tile(lds, 1, Cb + (size_t)(NT > 1 ? 64 : 0) * LDU, Cb + (size_t)(NT > 1 ? 64 : 0) * LDU, LDU, wid, lane);
    const bool late = wid >= 4; int prev_bo = 0; bf16x8 pa0 = {}, pa1 = {}, pa2 = {}, pa3 = {};
    for (int j = 0; j < NT; ++j) {
        const int bo = (j % NSLOT) * TILE_B;
        asm volatile("s_waitcnt vmcnt(4)" ::: "memory");
        ATT_BAR();
        const unsigned long long mw2 = mrow[j + 2 < NT ? j + 2 : 0];
        { const int jn = j + 2 < NT ? j + 2 : 0;
          dma_tile(lds, (j + 2) % NSLOT, Cb + (size_t)jn * 64 * LDU, Cb + (size_t)jn * 64 * LDU, LDU, wid, lane); }
        if (late && j > 0) pv_d0(o, vb0 + prev_bo, pa0, pa1, pa2, pa3);
        f32x16 p0, p1;
        qkt(p0, p1, lds + K_OFF + bo, qr, r32, hi);
        { const unsigned wlo = (unsigned)mw >> (4 * hi), whi = (unsigned)(mw >> 32) >> (4 * hi);
#pragma unroll
          for (int r = 0; r < 16; ++r) { const int bit = (r & 3) + 8 * (r >> 2);
              const unsigned m0 = (unsigned)(((int)(wlo << (31 - bit))) >> 31), m1 = (unsigned)(((int)(whi << (31 - bit))) >> 31);
              p0[r] = u2f((f2u(p0[r]) & m0) | (0xff800000u & ~m0));
              p1[r] = u2f((f2u(p1[r]) & m1) | (0xff800000u & ~m1)); } }
        float pmax = p0[0];
#pragma unroll
        for (int r = 1; r < 16; ++r) pmax = fmaxf(pmax, p0[r]);
#pragma unroll
        for (int r = 0; r < 16; ++r) pmax = fmaxf(pmax, p1[r]);
        pmax = lo_hi_max(pmax);
        float mn, alpha;
        if (__all(pmax - m_reg <= THR / SCALE)) { mn = m_reg; alpha = 1.f; }
        else { mn = fmaxf(m_reg, pmax); alpha = __builtin_amdgcn_exp2f((m_reg - mn) * C); m_reg = mn; }
        const float mnC = -mn * C;
#pragma unroll
        for (int r = 0; r < 16; ++r) { p0[r] = __builtin_amdgcn_exp2f(fmaf(p0[r], C, mnC)); p1[r] = __builtin_amdgcn_exp2f(fmaf(p1[r], C, mnC)); }
        float ps = 0.f;
#pragma unroll
        for (int r = 0; r < 16; ++r) ps += p0[r] + p1[r];
        ps = lo_hi_sum(ps);
        l_reg = l_reg * alpha + ps;
        pack_p(p0, p1, pa0, pa1, pa2, pa3);
        if (__any(alpha < 1.f)) { if (hi == 0) al_l[r32] = alpha; asm volatile("s_waitcnt lgkmcnt(0)" ::: "memory");
#pragma unroll
            for (int d = 0; d < 4; ++d)
#pragma unroll
                for (int r = 0; r < 16; ++r) o[d][r] *= al_l[crow(r, hi)]; }
        if (late) prev_bo = bo; else pv_d0(o, vb0 + bo, pa0, pa1, pa2, pa3);
        mw = mw1; mw1 = mw2;
    }
    if (late) pv_d0(o, vb0 + prev_bo, pa0, pa1, pa2, pa3);
    asm volatile("s_waitcnt vmcnt(0)" ::: "memory"); ATT_BAR();
    __builtin_amdgcn_s_setprio(0);
    if (hi == 0) li_l[r32] = l_reg; asm volatile("s_waitcnt lgkmcnt(0)" ::: "memory");
    LAS unsigned char* ost = lds + K_OFF + wid * 8192;
#pragma unroll
    for (int r = 0; r < 16; ++r) { const int orow = crow(r, hi); const float rl = __builtin_amdgcn_rcpf(li_l[orow]);
#pragma unroll
        for (int d0 = 0; d0 < 4; ++d0) *(LAS unsigned short*)(ost + orow * 256 + (32 * d0 + r32) * 2) = (unsigned short)f2bf(o[d0][r] * rl); }
    asm volatile("s_waitcnt lgkmcnt(0)" ::: "memory");
    bf16* Ow = OB + (size_t)(b * SEQ + qb * 32 + wid * 4) * DM;
#pragma unroll
    for (int k = 0; k < 8; ++k) { const int orow = 4 * k + (lane >> 4); const v4u w = *(LAS const v4u*)(ost + orow * 256 + (lane & 15) * 16);
        *(v4u*)(Ow + (size_t)(orow >> 3) * DM + (orow & 7) * 128 + (lane & 15) * 8) = w; }
    asm volatile("s_waitcnt lgkmcnt(0)" ::: "memory");
}
__device__ __forceinline__ void dsa_attn_phase(Frame& F) {
    const bf16* U = (const bf16*)(F.ws + WS_BIG); const unsigned long long* MASK = (const unsigned long long*)(F.ws + WS_MASK); bf16* OB = (bf16*)(F.ws + WS_OB);
    for (int wg = F.vcu; wg < 256; wg += F.G) { const int b = wg >> 4, i = wg & 15;
#pragma unroll 1
        for (int k = 0; k < 4; ++k) { const int qb = k == 0 ? 63 - i : (k == 1 ? 32 + i : (k == 2 ? 31 - i : i)); dsa_attn_unit(F.lds, U, MASK, OB, b, qb); } }
}

__device__ __forceinline__ void sb_unit(LAS unsigned char* lds, const bf16* __restrict__ QKV, bf16* __restrict__ OB, int b, int h, int i) {
    constexpr float C = 0.088388347648318440f * 1.4426950408889634f, DONE_THR = 160.f;
    int tid_ = threadIdx.x; asm volatile("" : "+v"(tid_));
    const int tid = tid_, wid = __builtin_amdgcn_readfirstlane(tid >> 6), lane = tid & 63, r32 = lane & 31, hi = lane >> 5;
    LAS volatile unsigned* flags = (LAS volatile unsigned*)(lds + FLAG_OFF);
#if MK_SB_PROF
    LAS volatile unsigned* prof = (LAS volatile unsigned*)(lds + MISC_OFF) + 16; unsigned long long pt0 = __builtin_amdgcn_s_memrealtime();
#define SB_PROF(k) do { if (tid == 0) { const unsigned long long pt1 = __builtin_amdgcn_s_memrealtime(); prof[k] += (unsigned)(pt1 - pt0); pt0 = pt1; } } while (0)
#else
#define SB_PROF(k) do { } while (0)
#endif
    const int t = 256 * i + 32 * wid + r32;
    f32x16 o[4] = {}; bf16x8 qr[8];
    { const bf16* Qw = QKV + (size_t)(b * SEQ + t) * LDQKV + h * 128 + hi * 8;
#pragma unroll
      for (int d0 = 0; d0 < 8; ++d0) qr[d0] = *(const bf16x8*)(Qw + d0 * 16); }
    const bf16* Kb = QKV + (size_t)(b * SEQ) * LDQKV + 2048 + h * 128; const bf16* Vb = Kb + 2048;
    const int vb0 = (int)(uintptr_t)(lds + V_OFF) + v_rd_base(lane);
    const float f0 = hi ? 0.f : 1.f;
    float Rneg = 0.f;
    int jt = 4 * i + 3;
    if (wid >= 4) __builtin_amdgcn_s_setprio(1);
    __syncthreads();
    dma_tile(lds, 0, Kb + (size_t)(jt * 64) * LDQKV, Vb + (size_t)(jt * 64) * LDQKV, LDQKV, wid, lane);
    dma_tile(lds, 1, Kb + (size_t)((jt - 1) * 64) * LDQKV, Vb + (size_t)((jt - 1) * 64) * LDQKV, LDQKV, wid, lane);
    SB_PROF(0);
    const bool late = wid >= 4; bool have = false; int prev_bo = 0; bf16x8 pa0 = {}, pa1 = {}, pa2 = {}, pa3 = {};
    for (int it = 0; jt >= 0; ++it, --jt) {
        const int bo = (it % NSLOT) * TILE_B;
        asm volatile("s_waitcnt vmcnt(4)" ::: "memory");
        ATT_BAR();
        SB_PROF(3);
        { unsigned a = 1u;
#pragma unroll
          for (int w = 0; w < 8; ++w) a &= flags[((it + 1) & 1) * 8 + w];
          if (it > 0 && a) break; }
        { const int jn = jt >= 2 ? jt - 2 : 0;
          dma_tile(lds, (it + 2) % NSLOT, Kb + (size_t)(jn * 64) * LDQKV, Vb + (size_t)(jn * 64) * LDQKV, LDQKV, wid, lane); }
        const bool wdone = __all(Rneg > DONE_THR);
        if (late && have) { pv_d0(o, vb0 + prev_bo, pa0, pa1, pa2, pa3); have = false; }
        if (!wdone) {
            const int kbase = jt * 64 + 4 * hi - t;
            const bool diag = jt >= 4 * i;
#define SB_HALF(KOFF, KD0, PA, PB) do { \
            f32x16 p = {}; \
            _Pragma("unroll") for (int d0 = 0; d0 < 8; ++d0) { const int cb = (d0 * 16 + hi * 8) * 2; \
                const bf16x8 kf = *(LAS const bf16x8*)(lds + K_OFF + bo + ATT_KSWZ((KOFF) + r32, cb)); p = __builtin_amdgcn_mfma_f32_32x32x16_bf16(kf, qr[d0], p, 0, 0, 0); } \
            _Pragma("unroll") for (int r = 0; r < 16; ++r) p[r] = fminf(p[r] * C, 64.f); \
            if (diag) { _Pragma("unroll") for (int r = 0; r < 16; ++r) { if (kbase + (KD0) + (r & 3) + 8 * (r >> 2) >= 0) p[r] = -1e30f; } } \
            f32x16 u1; \
            _Pragma("unroll") for (int r = 0; r < 16; ++r) { p[r] = __builtin_amdgcn_exp2f(p[r]); u1[r] = 1.0f + p[r]; }     \
            float Lo[4], Up[4]; \
            _Pragma("unroll") for (int g = 0; g < 4; ++g) { const float T = (u1[4 * g] * u1[4 * g + 1]) * (u1[4 * g + 2] * u1[4 * g + 3]); \
                auto rr = __builtin_amdgcn_permlane32_swap(f2u(T), f2u(T), false, false); \
                Lo[g] = u2f(rr[0]); Up[g] = u2f(rr[1]); } \
            const float cs = __builtin_amdgcn_exp2f(-Rneg); float run = 1.0f; \
            _Pragma("unroll") for (int g = 3; g >= 0; --g) { const float off = run * (hi ? 1.0f : Up[g]); run *= Up[g] * Lo[g]; \
                const float q3 = off * u1[4 * g + 3], q2 = q3 * u1[4 * g + 2], q1 = q2 * u1[4 * g + 1], q0 = q1 * u1[4 * g]; \
                p[4 * g + 3] *= __builtin_amdgcn_rcpf(q3) * cs; p[4 * g + 2] *= __builtin_amdgcn_rcpf(q2) * cs; p[4 * g + 1] *= __builtin_amdgcn_rcpf(q1) * cs; p[4 * g] *= __builtin_amdgcn_rcpf(q0) * cs; } \
            Rneg += __builtin_amdgcn_logf(run); \
            { unsigned a0 = cvtpk(p[0], p[1]), a1 = cvtpk(p[2], p[3]), b0 = cvtpk(p[4], p[5]), b1 = cvtpk(p[6], p[7]); \
              auto r0 = __builtin_amdgcn_permlane32_swap(a0, b0, false, false); auto r1 = __builtin_amdgcn_permlane32_swap(a1, b1, false, false); \
              u32x4v w = {r0[0], r1[0], r0[1], r1[1]}; PA = __builtin_bit_cast(bf16x8, w); } \
            { unsigned a0 = cvtpk(p[8], p[9]), a1 = cvtpk(p[10], p[11]), b0 = cvtpk(p[12], p[13]), b1 = cvtpk(p[14], p[15]); \
              auto r0 = __builtin_amdgcn_permlane32_swap(a0, b0, false, false); auto r1 = __builtin_amdgcn_permlane32_swap(a1, b1, false, false); \
              u32x4v w = {r0[0], r1[0], r0[1], r1[1]}; PB = __builtin_bit_cast(bf16x8, w); } } while (0)
            SB_HALF(32, 32, pa2, pa3);
            SB_HALF(0, 0, pa0, pa1);
#undef SB_HALF
            if (late) { have = true; prev_bo = bo; } else pv_d0(o, vb0 + bo, pa0, pa1, pa2, pa3);
        }
        if (lane == 0) flags[(it & 1) * 8 + wid] = wdone ? 1u : 0u;
        SB_PROF(1);
    }
    if (late && have) pv_d0(o, vb0 + prev_bo, pa0, pa1, pa2, pa3);
    asm volatile("s_waitcnt vmcnt(0)" ::: "memory"); ATT_BAR();
    __builtin_amdgcn_s_setprio(0);
    LAS unsigned char* ost = lds + K_OFF + wid * 8192;
#pragma unroll
    for (int r = 0; r < 16; ++r) { const int orow = crow(r, hi);
#pragma unroll
        for (int d0 = 0; d0 < 4; ++d0) *(LAS unsigned short*)(ost + orow * 256 + (32 * d0 + r32) * 2) = (unsigned short)f2bf(o[d0][r]); }
    asm volatile("s_waitcnt lgkmcnt(0)" ::: "memory");
    bf16* Ow = OB + (size_t)(b * SEQ + 256 * i + 32 * wid) * DM + h * 128;
#pragma unroll
    for (int k = 0; k < 8; ++k) { const int orow = 4 * k + (lane >> 4); const v4u w = *(LAS const v4u*)(ost + orow * 256 + (lane & 15) * 16);
        *(v4u*)(Ow + (size_t)orow * DM + (lane & 15) * 8) = w; }
    asm volatile("s_waitcnt lgkmcnt(0)" ::: "memory");
    SB_PROF(2);
#undef SB_PROF
}
__device__ __forceinline__ void sb_phase(Frame& F) {
    const bf16* QKV = (const bf16*)(F.ws + WS_BIG); bf16* OB = (bf16*)(F.ws + WS_HB);
    for (int wg = F.vcu; wg < 256; wg += F.G) { const int b = wg >> 4, h = wg & 15;
#pragma unroll 1
        for (int i = 7; i >= 0; --i) sb_unit(F.lds, QKV, OB, b, h, i); }
}
}
namespace idx {
constexpr int STAGE_KEYS = 256, STAGE_B = STAGE_KEYS * 128, NST = 3;
#define IDX_BAR() do { asm volatile("s_waitcnt lgkmcnt(0)" ::: "memory"); __builtin_amdgcn_s_barrier(); asm volatile("" ::: "memory"); } while (0)
__device__ __forceinline__ unsigned mono(float f) { const unsigned u = __builtin_bit_cast(unsigned, f); return u ^ ((unsigned)((int)u >> 31) | 0x80000000u); }
__device__ __forceinline__ void topk_unit(LAS unsigned char* lds, const bf16* __restrict__ U, unsigned* __restrict__ MASKW, int b, int g) {
    int tid_ = threadIdx.x; asm volatile("" : "+v"(tid_));
    const int tid = tid_, wid = __builtin_amdgcn_readfirstlane(tid >> 6), lane = tid & 63, r32 = lane & 31, hi = lane >> 5;
    const int t0 = 16 * g, nk = ((t0 >> 6) + 1) << 6, ntile = nk >> 5, nstage = (nk + STAGE_KEYS - 1) / STAGE_KEYS;
#if MK_IDX_PROF
    LAS volatile unsigned* prof = (LAS volatile unsigned*)(lds + MISC_OFF) + 16; unsigned long long pt0 = __builtin_amdgcn_s_memrealtime();
#define IDX_PROF(k) do { if (tid == 0) { const unsigned long long pt1 = __builtin_amdgcn_s_memrealtime(); prof[k] += (unsigned)(pt1 - pt0); pt0 = pt1; } } while (0)
#else
#define IDX_PROF(k) do { } while (0)
#endif
    const int tok0 = b * SEQ + t0 + 2 * wid;
    bf16x8 qa[4]; float wq[16];
    { const bf16* qp = U + (size_t)(tok0 + (r32 >> 4)) * LDU + U_QI + (r32 & 15) * 64 + hi * 8;
#pragma unroll
      for (int ks = 0; ks < 4; ++ks) qa[ks] = *(const bf16x8*)(qp + ks * 16);
#pragma unroll
      for (int q = 0; q < 2; ++q)
#pragma unroll
          for (int blk = 0; blk < 2; ++blk) { const v2u w = *(const v2u*)(U + (size_t)(tok0 + q) * LDU + U_WI + 8 * blk + 4 * hi);
              wq[8 * q + 4 * blk + 0] = bflo(w.x); wq[8 * q + 4 * blk + 1] = bfhi(w.x); wq[8 * q + 4 * blk + 2] = bflo(w.y); wq[8 * q + 4 * blk + 3] = bfhi(w.y); } }
    const bf16* kg = U + (size_t)(b * SEQ + (lane >> 3)) * LDU + U_KI + (((lane & 7) ^ (lane >> 3)) * 8);
#define IDX_DMA(SLOT, STG) do { _Pragma("unroll") for (int e = 0; e < 4; ++e) { const int kk = 4 * wid + e; \
        __builtin_amdgcn_global_load_lds((const unsigned*)(kg + (size_t)((STG) * STAGE_KEYS + 8 * kk) * LDU), (LAS unsigned*)(lds + (SLOT) * STAGE_B + kk * 1024), 16, 0, 0); } } while (0)
    __syncthreads();
    IDX_DMA(0, 0); IDX_DMA(1, (nstage > 1 ? 1 : 0));
    float sc[64];
#pragma unroll
    for (int i = 0; i < 64; ++i) sc[i] = -__builtin_inff();
    const int rdrow = r32 * 128, rdx = r32 & 7;
#pragma unroll
    for (int s = 0; s < 8; ++s) {
        if (s < nstage) {
            asm volatile("s_waitcnt vmcnt(4)" ::: "memory");
            IDX_BAR();
            IDX_DMA((s + 2) % NST, (s + 2 < nstage ? s + 2 : 0));
            LAS const unsigned char* kb = lds + (s % NST) * STAGE_B + rdrow;
#pragma unroll
            for (int tp = 0; tp < 4; ++tp) {
                const int i = s * 8 + 2 * tp;
                if (i < ntile) {
                    f32x16 acc0 = {}, acc1 = {};
#pragma unroll
                    for (int ks = 0; ks < 4; ++ks) { const bf16x8 kf0 = *(LAS const bf16x8*)(kb + (2 * tp) * 32 * 128 + (((2 * ks + hi) ^ rdx) * 16)), kf1 = *(LAS const bf16x8*)(kb + (2 * tp + 1) * 32 * 128 + (((2 * ks + hi) ^ rdx) * 16));
                        acc0 = __builtin_amdgcn_mfma_f32_32x32x16_bf16(qa[ks], kf0, acc0, 0, 0, 0); acc1 = __builtin_amdgcn_mfma_f32_32x32x16_bf16(qa[ks], kf1, acc1, 0, 0, 0); }
                    float p0 = 0.f, p1 = 0.f, p2 = 0.f, p3 = 0.f;
#pragma unroll
                    for (int r = 0; r < 8; ++r) { p0 = fmaf(wq[r], fmaxf(acc0[r], 0.f), p0); p1 = fmaf(wq[8 + r], fmaxf(acc0[8 + r], 0.f), p1); p2 = fmaf(wq[r], fmaxf(acc1[r], 0.f), p2); p3 = fmaf(wq[8 + r], fmaxf(acc1[8 + r], 0.f), p3); }
                    auto ra = __builtin_amdgcn_permlane32_swap(f2u(p0), f2u(p1), false, false); auto rb = __builtin_amdgcn_permlane32_swap(f2u(p2), f2u(p3), false, false);
                    sc[i] = (u2f(ra[0]) + u2f(ra[1])) * 0.03125f; sc[i + 1] = (u2f(rb[0]) + u2f(rb[1])) * 0.03125f;
                }
            }
        }
    }
    asm volatile("s_waitcnt vmcnt(0)" ::: "memory"); IDX_BAR();
#undef IDX_DMA
    IDX_PROF(0);
    float Tv = -__builtin_inff(); int rem0 = 0, rem1 = 0;
    if (nk > 256) {
        float mn = __builtin_inff(), mx = -__builtin_inff();
#pragma unroll
        for (int i = 0; i < 64; ++i) if (i < ntile) { mn = fminf(mn, sc[i]); mx = fmaxf(mx, sc[i]); }
#pragma unroll
        for (int o = 1; o < 32; o <<= 1) { mn = fminf(mn, __shfl_xor(mn, o)); mx = fmaxf(mx, __shfl_xor(mx, o)); }
        const unsigned mxu = f2u(mx);
        float lo = mn, hx = (mx == 0.f) ? 1.17549435e-38f : u2f((int)mxu >= 0 ? mxu + 1u : mxu - 1u);
        float flo = (float)nk - 255.5f, fhx = -255.5f;
        int side = 0;
        bool d0 = false, d1 = false;
#define IDX_BITS(BA, BB, EXPR) do { BA = 0u; BB = 0u; \
            _Pragma("unroll") for (int s = 0; s < 4; ++s) if (s < nstage) { _Pragma("unroll") for (int tt = 0; tt < 8; ++tt) { const float v_ = sc[s * 8 + tt]; BA = __builtin_amdgcn_alignbit(BA, f2u(EXPR), 31); } } \
            _Pragma("unroll") for (int s = 4; s < 8; ++s) if (s < nstage) { _Pragma("unroll") for (int tt = 0; tt < 8; ++tt) { const float v_ = sc[s * 8 + tt]; BB = __builtin_amdgcn_alignbit(BB, f2u(EXPR), 31); } } } while (0)
#define IDX_HALFSUM(N, C) do { int c_ = (C); \
            c_ += __builtin_amdgcn_update_dpp(0, c_, 0xB1, 0xF, 0xF, true); c_ += __builtin_amdgcn_update_dpp(0, c_, 0x4E, 0xF, 0xF, true);        \
            c_ += __builtin_amdgcn_update_dpp(0, c_, 0x124, 0xF, 0xF, true); c_ += __builtin_amdgcn_update_dpp(0, c_, 0x128, 0xF, 0xF, true);      \
            auto r_ = __builtin_amdgcn_permlane16_swap((unsigned)c_, (unsigned)c_, false, false); N = (int)r_[0] + (int)r_[1]; } while (0)
#pragma unroll 1
        for (int it = 0; it < 360; ++it) {
            const float fr = it < 24 ? flo * __builtin_amdgcn_rcpf(flo - fhx) : 0.5f;
            float mid = lo * (1.0f - fr) + hx * fr;
            if (!(mid > lo && mid < hx)) mid = lo * 0.5f + hx * 0.5f;
            const bool adj = !(mid > lo && mid < hx);
            const unsigned long long am = __builtin_amdgcn_ballot_w64(adj);
            if ((unsigned)am) d0 = true; if ((unsigned)(am >> 32)) d1 = true;
            if (d0 && d1) break;
            int nh; { unsigned ba, bb; IDX_BITS(ba, bb, v_ - mid); IDX_HALFSUM(nh, 8 * (nstage < 8 ? nstage : 8) - __builtin_popcount(ba) - __builtin_popcount(bb)); }
            const bool dh = hi ? d1 : d0;
            if (!dh) { const float f = (float)nh - 255.5f;
                if (nh >= 256) { lo = mid; flo = f; if (side > 0) fhx *= 0.5f; side = 1; }
                else { hx = mid; fhx = f; if (side < 0) flo *= 0.5f; side = -1; } }
            const unsigned long long hm = __builtin_amdgcn_ballot_w64(nh == 256);
            if ((unsigned)hm) d0 = true; if ((unsigned)(hm >> 32)) d1 = true;
        }
        { int ng; unsigned ba, bb; IDX_BITS(ba, bb, lo - v_); IDX_HALFSUM(ng, __builtin_popcount(ba) + __builtin_popcount(bb)); rem0 = 256 - __builtin_amdgcn_readfirstlane(ng); rem1 = 256 - __builtin_amdgcn_readlane(ng, 32); }
#undef IDX_BITS
#undef IDX_HALFSUM
        Tv = lo;
    }
    IDX_PROF(1);
    unsigned m0 = 0u, m1 = 0u;
#pragma unroll
    for (int i = 0; i < 64; ++i) {
        const unsigned long long gt = __builtin_amdgcn_ballot_w64(sc[i] > Tv);
        unsigned w0 = (unsigned)gt, w1 = (unsigned)(gt >> 32);
        if (rem0 | rem1) {
            const unsigned long long eq = __builtin_amdgcn_ballot_w64(sc[i] == Tv);
            unsigned e0 = rem0 > 0 ? (unsigned)eq : 0u, e1 = rem1 > 0 ? (unsigned)(eq >> 32) : 0u;
            while (__builtin_popcount(e0) > rem0) e0 &= ~(0x80000000u >> __builtin_clz(e0));
            while (__builtin_popcount(e1) > rem1) e1 &= ~(0x80000000u >> __builtin_clz(e1));
            rem0 -= __builtin_popcount(e0); rem1 -= __builtin_popcount(e1); w0 |= e0; w1 |= e1;
        }
        m0 = (lane == i) ? w0 : m0; m1 = (lane == i) ? w1 : m1;
    }
    __hip_atomic_store(MASKW + (size_t)tok0 * 64 + lane, m0, __ATOMIC_RELAXED, __HIP_MEMORY_SCOPE_AGENT); __hip_atomic_store(MASKW + (size_t)(tok0 + 1) * 64 + lane, m1, __ATOMIC_RELAXED, __HIP_MEMORY_SCOPE_AGENT);
    IDX_PROF(2);
#undef IDX_PROF
}
}
namespace gla {
constexpr int QE_OFF = 0, KE_OFF = 17408, KDT_OFF = 34816, ATT_OFF = 53248, O_OFF = 0, V_OFF = 66560, G_OFF = 99328, LR_OFF = 132096, TOT_OFF = 136192, DEC_OFF = 140288, WG_OFF = 140800, BG_OFF = 148992, GN_OFF = 149504;
constexpr int QP = 272, KTP = 144, VP = 512, OP = 1040;
#define GLA_BAR() do { asm volatile("s_waitcnt lgkmcnt(0)" ::: "memory"); __builtin_amdgcn_s_barrier(); asm volatile("" ::: "memory"); } while (0)
__device__ __forceinline__ s16x4 tr_read0(int addr) { s16x4 r; asm volatile("ds_read_b64_tr_b16 %0, %1" : "=&v"(r) : "v"(addr) : "memory"); return r; }
__device__ __forceinline__ void gla_unit(LAS unsigned char* lds, const bf16* __restrict__ U, const float* __restrict__ w_gk, const float* __restrict__ b_gk, const float* __restrict__ gnorm, bf16* __restrict__ OB, int b, int h) {
    constexpr float LOG2E = 1.4426950408889634f;
    int tid_ = threadIdx.x; asm volatile("" : "+v"(tid_));
    const int tid = tid_, wid = __builtin_amdgcn_readfirstlane(tid >> 6), lane = tid & 63, r32 = lane & 31, hi = lane >> 5;
    const int d0 = 2 * lane;
    LAS float* WG = (LAS float*)(lds + WG_OFF); LAS float* BG = (LAS float*)(lds + BG_OFF); LAS float* GN = (LAS float*)(lds + GN_OFF);
    __syncthreads();
#pragma unroll
    for (int k = 0; k < 4; ++k) { const int e = tid + 512 * k, r = e >> 7, d = e & 127; WG[r * 128 + d] = w_gk[r * 512 + h * 128 + d]; }
    if (tid < 128) BG[tid] = b_gk[h * 128 + tid];
    if (tid < 256) GN[tid] = gnorm[tid];
    f32x16 S[4] = {};
    LAS float* LR = (LAS float*)(lds + LR_OFF); LAS float* TOT = (LAS float*)(lds + TOT_OFF); LAS float* DEC = (LAS float*)(lds + DEC_OFF);
    const int ldsb = (int)(uintptr_t)lds;
    const int vtr = ldsb + V_OFF + (8 * (lane >> 5) + ((lane & 15) >> 2)) * VP + (32 * wid + 16 * ((lane >> 4) & 1) + 4 * (lane & 3)) * 2;
#define GLA_DMA(LOFF, COL0, TOK) do { _Pragma("unroll") for (int k4 = 0; k4 < 4; ++k4) { const int kk = wid * 4 + k4; \
        __builtin_amdgcn_global_load_lds((const unsigned*)(U + (size_t)((TOK) + 2 * kk + (lane >> 5)) * LDU + (COL0) + h * 256 + (lane & 31) * 8), (LAS unsigned*)(lds + (LOFF) + kk * 1024), 16, 0, 0); } } while (0)
    unsigned lrw, qw[8], kw[8];
    { const int tokp = b * SEQ; GLA_DMA(V_OFF, U_VB, tokp); GLA_DMA(G_OFF, U_GB, tokp);
      lrw = *(const unsigned*)(U + (size_t)(tokp + (tid >> 3)) * LDU + U_LR + (tid & 7) * 2);
#pragma unroll
      for (int j = 0; j < 8; ++j) { const bf16* up = U + (size_t)(tokp + 8 * wid + j) * LDU + h * 128 + d0; qw[j] = *(const unsigned*)(up + U_QB); kw[j] = *(const unsigned*)(up + U_KB); } }
#if MK_GLA_PROF
    LAS volatile unsigned* prof = (LAS volatile unsigned*)(lds + MISC_OFF) + 16; unsigned long long pt0 = __builtin_amdgcn_s_memrealtime();
#define GLA_PROF(k) do { if (tid == 0) { const unsigned long long pt1 = __builtin_amdgcn_s_memrealtime(); prof[k] += (unsigned)(pt1 - pt0); pt0 = pt1; } } while (0)
#else
#define GLA_PROF(k) do { } while (0)
#endif
#pragma unroll 1
    for (int n = 0; n < 32; ++n) {
        const int tok0 = b * SEQ + n * 64, tokn = tok0 + (n < 31 ? 64 : 0);
        { const int c = tid >> 3, r0 = (tid & 7) * 2; LR[c * 16 + r0] = bflo(lrw); LR[c * 16 + r0 + 1] = bfhi(lrw); }
        GLA_BAR();
        float G[2][8];
        f32x4 w0[4], w1[4];
#pragma unroll
        for (int r4 = 0; r4 < 4; ++r4)
#pragma unroll
            for (int e = 0; e < 4; ++e) { const f32x2 wv = *(LAS const f32x2*)(WG + (4 * r4 + e) * 128 + d0); w0[r4][e] = wv.x; w1[r4][e] = wv.y; }
        const f32x2 bg2 = *(LAS const f32x2*)(BG + d0);
#pragma unroll
        for (int j = 0; j < 8; ++j) { const int c = 8 * wid + j; float x0 = bg2.x, x1 = bg2.y;
#pragma unroll
            for (int r4 = 0; r4 < 4; ++r4) { const f32x4 l4 = *(LAS const f32x4*)(LR + c * 16 + 4 * r4);
#pragma unroll
                for (int e = 0; e < 4; ++e) { x0 = fmaf(l4[e], w0[r4][e], x0); x1 = fmaf(l4[e], w1[r4][e], x1); } }
            const float g0 = (fminf(x0, 0.f) * LOG2E - __builtin_amdgcn_logf(1.0f + __builtin_amdgcn_exp2f(-__builtin_fabsf(x0) * LOG2E))) * 0.0625f;
            const float g1 = (fminf(x1, 0.f) * LOG2E - __builtin_amdgcn_logf(1.0f + __builtin_amdgcn_exp2f(-__builtin_fabsf(x1) * LOG2E))) * 0.0625f;
            G[0][j] = g0 + (j ? G[0][j - 1] : 0.f); G[1][j] = g1 + (j ? G[1][j - 1] : 0.f); }
        TOT[wid * 128 + d0] = G[0][7]; TOT[wid * 128 + d0 + 1] = G[1][7];
        GLA_BAR();
        GLA_PROF(0);
        float off0 = 0.f, off1 = 0.f, gl0 = 0.f, gl1 = 0.f;
#pragma unroll
        for (int w = 0; w < 8; ++w) { const f32x2 t2 = *(LAS const f32x2*)(TOT + w * 128 + d0); if (w < wid) { off0 += t2.x; off1 += t2.y; } gl0 += t2.x; gl1 += t2.y; }
#pragma unroll
        for (int j = 0; j < 8; ++j) { const int c = 8 * wid + j; const float G0 = G[0][j] + off0, G1 = G[1][j] + off1;
            const float e0 = __builtin_amdgcn_exp2f(G0), e1 = __builtin_amdgcn_exp2f(G1), i0 = __builtin_amdgcn_exp2f(-G0), i1 = __builtin_amdgcn_exp2f(-G1);
            const float x0 = __builtin_amdgcn_exp2f(gl0 - G0), x1 = __builtin_amdgcn_exp2f(gl1 - G1);
            const float q0 = bflo(qw[j]), q1 = bfhi(qw[j]), k0 = bflo(kw[j]), k1 = bfhi(kw[j]);
            *(LAS unsigned*)(lds + QE_OFF + c * QP + d0 * 2) = pk2(q0 * e0 * 0.08838834764831845f, q1 * e1 * 0.08838834764831845f);
            *(LAS unsigned*)(lds + KE_OFF + c * QP + d0 * 2) = pk2(k0 * i0, k1 * i1);
            *(LAS unsigned short*)(lds + KDT_OFF + d0 * KTP + c * 2) = (unsigned short)f2bf(k0 * x0);
            *(LAS unsigned short*)(lds + KDT_OFF + (d0 + 1) * KTP + c * 2) = (unsigned short)f2bf(k1 * x1); }
        if (wid == 0) { DEC[d0] = __builtin_amdgcn_exp2f(gl0); DEC[d0 + 1] = __builtin_amdgcn_exp2f(gl1); }
        GLA_BAR();
        GLA_PROF(1);
        if (wid < 3) { const int rt = wid ? 1 : 0, ct = wid == 2 ? 1 : 0; f32x16 acc = {};
#pragma unroll
            for (int ks = 0; ks < 8; ++ks) { const bf16x8 a = *(LAS const bf16x8*)(lds + KE_OFF + (32 * ct + r32) * QP + (16 * ks + 8 * hi) * 2);
                const bf16x8 bq = *(LAS const bf16x8*)(lds + QE_OFF + (32 * rt + r32) * QP + (16 * ks + 8 * hi) * 2);
                acc = __builtin_amdgcn_mfma_f32_32x32x16_bf16(a, bq, acc, 0, 0, 0); }
            const int c = 32 * rt + r32;
#pragma unroll
            for (int q4 = 0; q4 < 4; ++q4) { const int s0 = 32 * ct + 8 * q4 + 4 * hi; float v[4];
#pragma unroll
                for (int e = 0; e < 4; ++e) v[e] = (s0 + e <= c) ? acc[4 * q4 + e] : 0.f;
                v2u w; w.x = pk2(v[0], v[1]); w.y = pk2(v[2], v[3]); *(LAS v2u*)(lds + ATT_OFF + c * KTP + s0 * 2) = w; } }
        asm volatile("s_waitcnt vmcnt(0)" ::: "memory");
        GLA_BAR();
        GLA_PROF(2);
        lrw = *(const unsigned*)(U + (size_t)(tokn + (tid >> 3)) * LDU + U_LR + (tid & 7) * 2);
#pragma unroll
        for (int j = 0; j < 8; ++j) { const bf16* up = U + (size_t)(tokn + 8 * wid + j) * LDU + h * 128 + d0; qw[j] = *(const unsigned*)(up + U_QB); kw[j] = *(const unsigned*)(up + U_KB); }
        bf16x8 vf[4];
        { s16x4 tl[4], th[4];
#pragma unroll
          for (int ks = 0; ks < 4; ++ks) { tl[ks] = tr_read0(vtr + (16 * ks) * VP); th[ks] = tr_read0(vtr + (16 * ks + 4) * VP); }
          asm volatile("s_waitcnt lgkmcnt(0)" ::: "memory"); __builtin_amdgcn_sched_barrier(0);
#pragma unroll
          for (int ks = 0; ks < 4; ++ks) vf[ks] = (bf16x8){tl[ks][0], tl[ks][1], tl[ks][2], tl[ks][3], th[ks][0], th[ks][1], th[ks][2], th[ks][3]}; }
        f32x16 o0 = {}, o1 = {};
#pragma unroll
        for (int ks = 0; ks < 4; ++ks) { const bf16x8 a1 = *(LAS const bf16x8*)(lds + ATT_OFF + (32 + r32) * KTP + (16 * ks + 8 * hi) * 2);
            o1 = __builtin_amdgcn_mfma_f32_32x32x16_bf16(a1, vf[ks], o1, 0, 0, 0);
            if (ks < 2) { const bf16x8 a0 = *(LAS const bf16x8*)(lds + ATT_OFF + r32 * KTP + (16 * ks + 8 * hi) * 2); o0 = __builtin_amdgcn_mfma_f32_32x32x16_bf16(a0, vf[ks], o0, 0, 0, 0); } }
#pragma unroll
        for (int kb = 0; kb < 4; ++kb)
#pragma unroll
            for (int s2 = 0; s2 < 2; ++s2) {
                att::u32x4v sw; sw.x = att::cvtpk(S[kb][8 * s2 + 0], S[kb][8 * s2 + 1]); sw.y = att::cvtpk(S[kb][8 * s2 + 2], S[kb][8 * s2 + 3]);
                sw.z = att::cvtpk(S[kb][8 * s2 + 4], S[kb][8 * s2 + 5]); sw.w = att::cvtpk(S[kb][8 * s2 + 6], S[kb][8 * s2 + 7]);
                const bf16x8 sb = __builtin_bit_cast(bf16x8, sw);
                const int col = 32 * kb + 16 * s2 + 4 * hi;
                const v2u qa0 = *(LAS const v2u*)(lds + QE_OFF + r32 * QP + col * 2), qa1 = *(LAS const v2u*)(lds + QE_OFF + r32 * QP + (col + 8) * 2);
                const v2u qb0 = *(LAS const v2u*)(lds + QE_OFF + (32 + r32) * QP + col * 2), qb1 = *(LAS const v2u*)(lds + QE_OFF + (32 + r32) * QP + (col + 8) * 2);
                const att::u32x4v A0 = {qa0.x, qa0.y, qa1.x, qa1.y}, A1 = {qb0.x, qb0.y, qb1.x, qb1.y};
                o0 = __builtin_amdgcn_mfma_f32_32x32x16_bf16(__builtin_bit_cast(bf16x8, A0), sb, o0, 0, 0, 0);
                o1 = __builtin_amdgcn_mfma_f32_32x32x16_bf16(__builtin_bit_cast(bf16x8, A1), sb, o1, 0, 0, 0); }
#pragma unroll
        for (int kb = 0; kb < 4; ++kb) {
#pragma unroll
            for (int q4 = 0; q4 < 4; ++q4) { const f32x4 dc = *(LAS const f32x4*)(DEC + 32 * kb + 8 * q4 + 4 * hi);
#pragma unroll
                for (int e = 0; e < 4; ++e) S[kb][4 * q4 + e] *= dc[e]; }
#pragma unroll
            for (int ks = 0; ks < 4; ++ks) { const bf16x8 a = *(LAS const bf16x8*)(lds + KDT_OFF + (32 * kb + r32) * KTP + (16 * ks + 8 * hi) * 2);
                S[kb] = __builtin_amdgcn_mfma_f32_32x32x16_bf16(a, vf[ks], S[kb], 0, 0, 0); } }
        GLA_BAR();
        GLA_PROF(3);
        GLA_DMA(V_OFF, U_VB, tokn);
#pragma unroll
        for (int r = 0; r < 16; ++r) { const int c = att::crow(r, hi);
            *(LAS float*)(lds + O_OFF + c * OP + (32 * wid + r32) * 4) = o0[r]; *(LAS float*)(lds + O_OFF + (32 + c) * OP + (32 * wid + r32) * 4) = o1[r]; }
        GLA_BAR();
        { const int c = tid >> 3, seg = tid & 7; f32x4 ov[8]; float ss = 0.f;
#pragma unroll
          for (int k = 0; k < 8; ++k) { ov[k] = *(LAS const f32x4*)(lds + O_OFF + c * OP + (32 * seg + 4 * k) * 4); ss += (ov[k].x * ov[k].x + ov[k].y * ov[k].y) + (ov[k].z * ov[k].z + ov[k].w * ov[k].w); }
          ss += __shfl_xor(ss, 1); ss += __shfl_xor(ss, 2); ss += __shfl_xor(ss, 4);
          const float rs = __builtin_amdgcn_rsqf(ss * (1.0f / 256.0f) + EPS);
          LAS const unsigned char* gp = lds + G_OFF + c * 512 + 32 * seg * 2; bf16* op = OB + (size_t)(tok0 + c) * DM + 1024 + h * 256 + 32 * seg;
#pragma unroll
          for (int k2 = 0; k2 < 4; ++k2) { const v4u gw = *(LAS const v4u*)(gp + 16 * k2); const f32x4 n0 = *(LAS const f32x4*)(GN + 32 * seg + 8 * k2), n1 = *(LAS const f32x4*)(GN + 32 * seg + 8 * k2 + 4);
              float gv[8] = {bflo(gw.x), bfhi(gw.x), bflo(gw.y), bfhi(gw.y), bflo(gw.z), bfhi(gw.z), bflo(gw.w), bfhi(gw.w)};
              float xv[8] = {ov[2 * k2].x * n0.x, ov[2 * k2].y * n0.y, ov[2 * k2].z * n0.z, ov[2 * k2].w * n0.w, ov[2 * k2 + 1].x * n1.x, ov[2 * k2 + 1].y * n1.y, ov[2 * k2 + 1].z * n1.z, ov[2 * k2 + 1].w * n1.w};
              float rv[8];
#pragma unroll
              for (int e = 0; e < 8; ++e) rv[e] = xv[e] * rs * gv[e];
              v4u w; w.x = pk2(rv[0], rv[1]); w.y = pk2(rv[2], rv[3]); w.z = pk2(rv[4], rv[5]); w.w = pk2(rv[6], rv[7]); *(v4u*)(op + 8 * k2) = w; } }
        GLA_BAR();
        GLA_PROF(4);
        GLA_DMA(G_OFF, U_GB, tokn);
    }
    asm volatile("s_waitcnt vmcnt(0)" ::: "memory"); GLA_BAR();
#undef GLA_DMA
#undef GLA_PROF
}
}
#ifndef MK_ONE_LAUNCH
#define MK_ONE_LAUNCH 1
#endif
#ifndef MK_NAIVE_DSA
#define MK_NAIVE_DSA 0
#endif
#ifndef MK_DSA_MODE
#define MK_DSA_MODE 0
#endif
#ifndef MK_NAIVE_GLA
#define MK_NAIVE_GLA 0
#endif
#ifndef MK_NAIVE_SB
#define MK_NAIVE_SB 0
#endif
#ifndef MK_STAGGER_TICKS
#define MK_STAGGER_TICKS 0
#define MK_STAGGER_CLS 4
#endif
#ifndef MK_GEMM_ALIGN
#define MK_GEMM_ALIGN true
#endif
#ifndef MK_GEMM_SP2
#define MK_GEMM_SP2 true
#endif
#ifndef MK_REP_MASK
#define MK_REP_MASK 0
#endif
#ifndef MK_SPIN_MULT
#define MK_SPIN_MULT 0
#define MK_SPIN_A 0
#define MK_SPIN_B 0
#endif
#ifndef MK_SPIN_BLOCK
#define MK_SPIN_BLOCK 0
#endif
constexpr int N_PHASES = 20;
struct Args { const float* in[19]; float* out; unsigned char* ws; int ph_lo, ph_hi; };
static_assert(sizeof(Args) == 19 * 8 + 8 + 8 + 8, "Args has no padding");

__global__ void __launch_bounds__(NWAVES * 64, 2) mk_fwd(Args args) {
    extern __shared__ __attribute__((aligned(16))) unsigned char lds[];
    Frame F;
    F.lds = (LAS unsigned char*)lds;
    F.MISC = (volatile LAS unsigned*)(F.lds + MISC_OFF);
    F.tid = threadIdx.x; F.lane = F.tid & 63; F.wave = __builtin_amdgcn_readfirstlane(F.tid >> 6);
    F.G = gridDim.x; { const int bx = blockIdx.x; F.vcu = (F.G % 8 == 0) ? (bx % 8) * (F.G / 8) + bx / 8 : bx; }
    unsigned char* ws = args.ws; F.ws = ws; F.out = args.out;
    F.ctl = (gu32*)(ws + WS_CTL);
#pragma unroll
    for (int i = 0; i < 19; ++i) F.in[i] = args.in[i];
    for (int u = F.tid; u < (LDS_BYTES - LDSCTL_OFF) / 4; u += NWAVES * 64) ((LAS unsigned*)(F.lds + LDSCTL_OFF))[u] = 0u;
    __syncthreads();
    XcdBarrier bar; bar.bar = (unsigned*)(F.ctl + CW_BAR); bar.x = 0; bar.st = nullptr;
    if (MK_ONE_LAUNCH) bar = xcd_barrier_post((unsigned*)(F.ctl + CW_BAR), F.MISC + 8);
#define GRID_BAR() do { if (MK_ONE_LAUNCH) xcd_barrier(bar); } while (0)
    unsigned long long st_a = 0ull, st_b = 0ull, ck_a = 0ull, ck_b = 0ull;
#define STAMP(i) do { if ((MK_SPIN_MULT || MK_CLK_PROBE) && bx0 == MK_SPIN_BLOCK && F.tid == 0) { if ((i) == MK_SPIN_A) { st_a = __builtin_amdgcn_s_memrealtime(); ck_a = __builtin_amdgcn_s_memtime(); } if ((i) == MK_SPIN_B) { st_b = __builtin_amdgcn_s_memrealtime(); ck_b = __builtin_amdgcn_s_memtime(); } } } while (0)
    const int bx0 = (int)blockIdx.x;
    STAMP(0);
    const int lo = args.ph_lo, hi = args.ph_hi;
#define IN(k) (lo <= (k) && (k) < hi)
#define BOTH(k) (IN(k) && (k) + 1 < hi)
    bf16* HB = (bf16*)(ws + WS_HB); float* SQA = (float*)(ws + WS_SSQA); float* SQB = (float*)(ws + WS_SSQB); bf16* BIG = (bf16*)(ws + WS_BIG); bf16* OB = (bf16*)(ws + WS_OB); bf16* PB = (bf16*)(ws + WS_PB);
    const int bx = (int)blockIdx.x;

#define GEMM_CALL(EPI, A_, BT_, N_, K_, ...) do { pg8::Gemm g{A_, (const bf16*)(BT_), MT, N_, K_}; pg8::StaticOrder S; S.init(MT, N_, F.G, bx); int rtag = -1; (void)rtag; \
        const pg8::RstdCache RC{&rtag, (LAS float*)(F.lds + 131072) + F.wave * 512}; (void)RC; pg8::EPI E{__VA_ARGS__}; \
        if (MK_STAGGER_TICKS && (N_) > 2048) { const unsigned long long t0_ = __builtin_amdgcn_s_memrealtime(), w_ = (unsigned long long)(((unsigned)F.vcu >> 5) & (MK_STAGGER_CLS - 1)) * MK_STAGGER_TICKS;   \
            while (__builtin_amdgcn_s_memrealtime() - t0_ < w_) __builtin_amdgcn_s_sleep(4); } \
        pg8::gemm_phase<pg8::EPI, pg8::StaticOrder, MK_GEMM_ALIGN, MK_GEMM_SP2>(F.lds + RING_OFF, g, S, E); } while (0)
#define BODY_0()  do { p0_prologue<1>(F); p0_prologue<0>(F); } while (0)
#define BODY_1()  GEMM_CALL(EpiScaleBf16, HB, ws + WS_WIN0, LDU, DM, BIG, LDU, SQA, RC, U_GB, U_LR)
#if !MK_NAIVE_GLA
#define BODY_2A() do { if (bx < 64) gla::gla_unit(F.lds, BIG, F.in[4], F.in[5], F.in[6], OB, bx >> 2, bx & 3); } while (0)
#else
#define BODY_2A() do { } while (0)
#endif
#if !MK_NAIVE_DSA && (MK_DSA_MODE == 0 || MK_DSA_MODE == 3)
#define BODY_2B(QW) do { __syncthreads(); if (F.tid == 0) F.MISC[0] = __hip_atomic_fetch_add((unsigned*)(F.ctl + (QW)), 1u, __ATOMIC_RELAXED, __HIP_MEMORY_SCOPE_AGENT); __syncthreads(); \
        int q = (int)F.MISC[0]; unsigned qn = 0u; gu32* flg = F.ctl + (QW) + CW_FLG_REL; \
          \
          \
        while (q < 3072) {                                                \
            if (F.tid == 0) qn = __hip_atomic_fetch_add((unsigned*)(F.ctl + (QW)), 1u, __ATOMIC_RELAXED, __HIP_MEMORY_SCOPE_AGENT); \
            if (q < 2048) { const int c = 31 - (q >> 6), rem = q & 63, b_ = rem >> 2, g_ = 4 * c + (rem & 3); \
                idx::topk_unit(F.lds, BIG, (unsigned*)(ws + WS_MASK), b_, g_);     \
                asm volatile("s_waitcnt vmcnt(0)" ::: "memory"); __syncthreads(); \
                if (F.tid == 0) { __hip_atomic_store((unsigned*)(flg + b_ * 128 + g_), 1u, __ATOMIC_RELAXED, __HIP_MEMORY_SCOPE_AGENT); F.MISC[0] = qn; } } \
            else { const int qa = q - 2048, qb_ = 63 - (qa >> 4), b_ = qa & 15; \
                if (F.tid == 0) { unsigned sp_ = 0u; \
                    while (__hip_atomic_load((unsigned*)(flg + b_ * 128 + 2 * qb_), __ATOMIC_RELAXED, __HIP_MEMORY_SCOPE_AGENT) == 0u || __hip_atomic_load((unsigned*)(flg + b_ * 128 + 2 * qb_ + 1), __ATOMIC_RELAXED, __HIP_MEMORY_SCOPE_AGENT) == 0u) { \
                        __builtin_amdgcn_s_sleep(2); if (++sp_ > (1u << 22)) break; }     \
                    __builtin_amdgcn_fence(__ATOMIC_ACQUIRE, "agent"); asm volatile("s_waitcnt vmcnt(0)" ::: "memory"); } \
                __syncthreads(); \
                att::dsa_attn_unit(F.lds, BIG, (const unsigned long long*)(ws + WS_MASK), OB, b_, qb_); \
                if (F.tid == 0) F.MISC[0] = qn; } \
            __syncthreads(); q = (int)F.MISC[0]; } } while (0)
#else
#define BODY_2B(QW) do { } while (0)
#endif
#define BODY_2()  do { BODY_2A(); STAMP(30); BODY_2B(CW_Q); STAMP(31); } while (0)
#if !MK_NAIVE_DSA && (MK_DSA_MODE == 0 || MK_DSA_MODE == 2)
#define BODY_3()  att::dsa_attn_phase(F)
#else
#define BODY_3()  do { } while (0)
#endif
#define BODY_4()  GEMM_CALL(EpiRes, OB, ws + WS_WOUT0, DM, DM, HB, HB, DM, SQA)
#define BODY_11() GEMM_CALL(EpiScaleBf16, OB, ws + WS_WIN1, LDQKV, DM, BIG, LDQKV, SQB, RC, 0, 0)
#if !MK_NAIVE_SB
#define BODY_12() att::sb_phase(F)
#else
#define BODY_12() do { } while (0)
#endif
#define BODY_13() GEMM_CALL(EpiRes, HB, ws + WS_WOUT1, DM, DM, OB, OB, DM, SQA)
#define BODY_NORM() norm_phase(F, F.out)
#define BODY_UP(l)   GEMM_CALL(EpiSwiglu, ((l) ? OB : HB), ws + WS_WGU + (size_t)(l) * 44 * MiB, 2 * FF, DM, BIG, FF, SQA, RC)
#define BODY_DOWN(l) GEMM_CALL(EpiRes, BIG, ws + WS_WD + (size_t)(l) * 22 * MiB, DM, FF, ((l) ? OB : HB), ((l) ? OB : HB), DM, SQA)
#define BODY_PE(l)   GEMM_CALL(EpiScaleBf16, PB + (size_t)(l) * MT * PLE, ws + WS_WPE + (size_t)(l) * 1 * MiB, DM, PLE, ((l) ? HB : OB), DM, nullptr, RC, 0, 0)
#define BODY_PLE0()  GEMM_CALL(EpiPle, HB, ws + WS_WPG, DM, DM, HB, OB, DM, SQA, SQB, RC)
#define BODY_PLE1()  GEMM_CALL(EpiPle, OB, ws + WS_WPG + (size_t)8 * MiB, DM, DM, OB, HB, DM, SQA, SQB, RC)
#define REP(k) ((MK_REP_MASK >> (k)) & 1)
#define PHASE(k, BODY) do { if (IN(k)) { BODY; if (REP(k)) { GRID_BAR(); BODY; } if (BOTH(k)) GRID_BAR(); STAMP((k) + 1); } } while (0)

    PHASE(0, BODY_0());
    PHASE(1, BODY_1());
    if (IN(2)) { BODY_2(); if (REP(2)) { GRID_BAR(); BODY_2A(); BODY_2B(CW_Q + 4096); } if (BOTH(2)) GRID_BAR(); STAMP(3); }
    if (IN(4)) { BODY_4(); if (BOTH(4)) GRID_BAR(); STAMP(5); }
    PHASE(6, BODY_UP(0));
    if (IN(7)) { BODY_DOWN(0); BODY_PE(0); if (BOTH(7)) GRID_BAR(); STAMP(8); }
    if (IN(9)) { BODY_PLE0(); if (BOTH(9)) GRID_BAR(); STAMP(10); }
    PHASE(11, BODY_11());
    PHASE(12, BODY_12());
    if (IN(13)) { BODY_13(); if (BOTH(13)) GRID_BAR(); STAMP(14); }
    PHASE(15, BODY_UP(1));
    if (IN(16)) { BODY_DOWN(1); BODY_PE(1); if (BOTH(16)) GRID_BAR(); STAMP(17); }
    if (IN(18)) { BODY_PLE1(); if (BOTH(18)) GRID_BAR(); STAMP(19); }
    if (IN(19)) { final_norm_phase(F); STAMP(20); }
#if MK_CLK_PROBE
    if (bx0 == MK_SPIN_BLOCK && F.tid == 0) { const unsigned long long dc = ck_b - ck_a, dr = st_b - st_a;
        const unsigned long long w = dc * 10000ull / dr, t0 = __builtin_amdgcn_s_memrealtime(); while (__builtin_amdgcn_s_memrealtime() - t0 < w) __builtin_amdgcn_s_sleep(8); }
#endif
    if (MK_SPIN_MULT && bx0 == MK_SPIN_BLOCK && F.tid == 0) { const unsigned long long t0 = __builtin_amdgcn_s_memrealtime(), w = ((MK_SB_PROF || MK_GEMM_PROF || MK_IDX_PROF || MK_GLA_PROF) ? (unsigned long long)F.MISC[16 + MK_SB_SEL] : (st_b - st_a)) * (unsigned long long)MK_SPIN_MULT; while (__builtin_amdgcn_s_memrealtime() - t0 < w) __builtin_amdgcn_s_sleep(8); }
#undef IN
#undef BOTH
}

extern "C" void kernel_launch(void* const* d_in, const int* in_sizes, int n_in, void* d_out, int out_size, void* d_ws, size_t ws_size, hipStream_t stream) {
    static int grid = 0;
    if (grid == 0) {
        if (n_in != 19 || in_sizes[0] != MT * DM || out_size != MT * DM || ws_size < WS_END) { fprintf(stderr, "kernel_launch: shape/workspace mismatch (n_in %d, ws %zu < %zu)\n", n_in, ws_size, (size_t)WS_END); grid = -1; return; }
        int dev = 0, cus = 0;
        if (hipGetDevice(&dev) != hipSuccess || hipDeviceGetAttribute(&cus, hipDeviceAttributeMultiprocessorCount, dev) != hipSuccess) { grid = -1; return; }
        if (hipFuncSetAttribute((const void*)mk_fwd, hipFuncAttributeMaxDynamicSharedMemorySize, LDS_BYTES) != hipSuccess) { fprintf(stderr, "kernel_launch: hipFuncSetAttribute failed\n"); grid = -1; return; }
        int per_cu = 0;
        if (hipOccupancyMaxActiveBlocksPerMultiprocessor(&per_cu, (const void*)mk_fwd, NWAVES * 64, LDS_BYTES) != hipSuccess || per_cu < 1) { fprintf(stderr, "kernel_launch: occupancy query says %d\n", per_cu); }
        (void)hipGetLastError();
        grid = cus;
    }
    if (grid < 0) return;
    hipMemsetAsync((char*)d_ws + WS_CTL, 0, CTL_ZERO_BYTES, stream);
    Args a{};
    for (int i = 0; i < 19; ++i) a.in[i] = (const float*)d_in[i];
    a.out = (float*)d_out; a.ws = (unsigned char*)d_ws;
    unsigned char* ws = (unsigned char*)d_ws;
#if MK_ONE_LAUNCH
    a.ph_lo = 0; a.ph_hi = N_PHASES;
    hipLaunchKernelGGL(mk_fwd, dim3(grid), dim3(NWAVES * 64), LDS_BYTES, stream, a);
#else
    for (int p = 0; p < N_PHASES; ++p) { a.ph_lo = p; a.ph_hi = p + 1; hipLaunchKernelGGL(mk_fwd, dim3(grid), dim3(NWAVES * 64), LDS_BYTES, stream, a); }
#endif
    const hipError_t le = hipPeekAtLastError();
    if (le != hipSuccess) fprintf(stderr, "kernel_launch: launch failed: %s\n", hipGetErrorName(le));
}
```

```cpp
#include <hip/hip_runtime.h>
#include <cstdio>
#include <cstdint>

#ifndef MK_GLA_PROF
#define MK_GLA_PROF 0
#endif
#ifndef MK_IDX_PROF
#define MK_IDX_PROF 0
#endif
#ifndef MK_GEMM_RELAX
#define MK_GEMM_RELAX 1
#endif
#ifndef MK_CLK_PROBE
#define MK_CLK_PROBE 0
#endif
#ifndef MK_GEMM_PROF
#define MK_GEMM_PROF 0
#endif
#ifndef MK_SB_PROF
#define MK_SB_PROF 0
#define MK_SB_SEL 0
#endif
constexpr int NB = 16, SEQ = 2048, DM = 2048, MT = NB * SEQ;
constexpr int PLE = 256, FF = 5632;
constexpr int EVEN_IN = 5344, LDU = 5376;
constexpr int U_QA = 0, U_CA = 1024, U_QI = 1152, U_KI = 2176, U_WI = 2240, U_QB = 2256, U_KB = 2768, U_VB = 3280, U_GB = 4304, U_LR = 5328;
constexpr int LDQKV = 6144;
constexpr float EPS = 1e-6f;
constexpr int NWAVES = 8;

constexpr size_t MiB = 1u << 20;
constexpr size_t WS_CTL = 0, CTL_ZERO_BYTES = 1 * MiB;
constexpr size_t WS_WIN0 = 1 * MiB;
constexpr size_t WS_WOUT0 = WS_WIN0 + 21 * MiB;
constexpr size_t WS_WIN1 = WS_WOUT0 + 8 * MiB;
constexpr size_t WS_WOUT1 = WS_WIN1 + 24 * MiB;
constexpr size_t WS_WGU = WS_WOUT1 + 8 * MiB;
constexpr size_t WS_WD = WS_WGU + 88 * MiB;
constexpr size_t WS_WPG = WS_WD + 44 * MiB;
constexpr size_t WS_WPE = WS_WPG + 16 * MiB;
constexpr size_t WS_SSQA = WS_WPE + 2 * MiB;
constexpr size_t WS_SSQB = WS_SSQA + 4 * MiB;
constexpr size_t WS_HB = WS_SSQB + 4 * MiB;
constexpr size_t WS_PB = WS_HB + 128 * MiB;
constexpr size_t WS_BIG = WS_PB + 32 * MiB;
constexpr size_t WS_OB = WS_BIG + 384 * MiB;
constexpr size_t WS_MASK = WS_OB + 128 * MiB;
constexpr size_t WS_H8 = WS_MASK + 8 * MiB;
constexpr size_t WS_END = WS_H8 + 64 * MiB;
static_assert(WS_END <= 1024 * MiB, "workspace map must fit 4 x 256 MiB");

constexpr int CW_TMO = 0, CW_CODE = 1, CW_BAR = 4096, CW_Q = 8192, CW_FLG_REL = 64;

constexpr int RING_OFF = 0, RING_BYTES = 151552;
constexpr int LDSCTL_OFF = RING_BYTES, MISC_OFF = LDSCTL_OFF + 320;
constexpr int LDS_BYTES = 155648;

#define GAS __attribute__((address_space(1)))
#define LAS __attribute__((address_space(3)))
typedef unsigned short bf16;
typedef unsigned v4u __attribute__((ext_vector_type(4)));
typedef unsigned v2u __attribute__((ext_vector_type(2)));
typedef float f32x4 __attribute__((ext_vector_type(4)));
typedef float f32x2 __attribute__((ext_vector_type(2)));
typedef float f32x16 __attribute__((ext_vector_type(16)));
typedef short bf16x8 __attribute__((ext_vector_type(8)));
typedef short s16x4 __attribute__((ext_vector_type(4)));
typedef GAS unsigned gu32;
#define RLX_AGENT __ATOMIC_RELAXED, __HIP_MEMORY_SCOPE_AGENT
#define LDS_WAIT() asm volatile("s_waitcnt lgkmcnt(0)" ::: "memory")
#define VM_WAIT() asm volatile("s_waitcnt vmcnt(0)" ::: "memory")
__device__ __forceinline__ unsigned f2bf(float f) { unsigned u = __builtin_bit_cast(unsigned, f); return (u + 0x7fffu + ((u >> 16) & 1u)) >> 16; }
__device__ __forceinline__ unsigned pk2(float lo, float hi) { return f2bf(lo) | (f2bf(hi) << 16); }
__device__ __forceinline__ float bf2f(unsigned short b) { return __builtin_bit_cast(float, ((unsigned)b) << 16); }
__device__ __forceinline__ float bflo(unsigned w) { return __builtin_bit_cast(float, w << 16); }
__device__ __forceinline__ float bfhi(unsigned w) { return __builtin_bit_cast(float, w & 0xffff0000u); }
__device__ __forceinline__ float u2f(unsigned u) { return __builtin_bit_cast(float, u); }
__device__ __forceinline__ unsigned f2u(float f) { return __builtin_bit_cast(unsigned, f); }
namespace pg8 {
#define PG8_LAS __attribute__((address_space(3)))
typedef unsigned short bf16_t;
typedef short bf16x8 __attribute__((ext_vector_type(8)));
typedef float f32x4 __attribute__((ext_vector_type(4)));
typedef unsigned u32x4 __attribute__((ext_vector_type(4)));
typedef int v4i_t __attribute__((ext_vector_type(4)));
typedef int v8i_t __attribute__((ext_vector_type(8)));
typedef unsigned u32x2 __attribute__((ext_vector_type(2)));
constexpr int BM = 256, BK = 64, HALF = 128, HTB = HALF * BK * 2  , STAGE_BYTES = 8 * HTB, NXCD = 8, WGM = 8;

__host__ __device__ __forceinline__ int lds_byte(int r, int c) { const int st = (r >> 4) * 2 + (c >> 5), rr = r & 15, cc = c & 31, ob = rr * 64 + cc * 2; return st * 1024 + (ob ^ (((ob >> 9) & 1) << 5)); }
__host__ __device__ __forceinline__ void stage_rc(int b, int& R, int& C) { const int st = b / 1024, sb = b % 1024, swz = sb ^ (((sb >> 9) & 1) << 5); R = (st >> 1) * 16 + swz / 64; C = (st & 1) * 32 + (swz % 64) / 2; }
__host__ __device__ __forceinline__ int perm32(int rho) { const int n = rho >> 4, i = rho & 15; return 8 * (i >> 2) + 4 * n + (i & 3); }

struct Unit { int pm, pn; };
struct Gemm { const bf16_t* A; const bf16_t* Bt; int M, N, K; };

struct StaticOrder {
    int nM, nN, nwg, G, c;
    __host__ __device__ void init(int M, int N, int G_, int c_) { nM = M / BM; nN = N / BM; nwg = nM * nN; G = G_; c = c_; }
    __host__ __device__ bool next(int i, Unit& u) const {
        const long L = (long)i * G + c; if (L >= nwg) return false;
        int wgid = (int)L; { const int q = nwg / NXCD, r = nwg % NXCD, xcd = wgid % NXCD, off = wgid / NXCD; wgid = (xcd < r ? xcd * (q + 1) : r * (q + 1) + (xcd - r) * q) + off; }
        const int wgm = (nN == 8) ? 4 : WGM;
        const int nig = wgm * nN, gid = wgid / nig, fm = gid * wgm, gsz = (nM - fm) < wgm ? (nM - fm) : wgm;
        u.pm = fm + ((wgid % nig) % gsz); u.pn = (wgid % nig) / gsz; return true;
    }
    __device__ __forceinline__ void a_ready(const Unit&) const {}
    __device__ __forceinline__ void done(const Unit&) const {}
};

__device__ __forceinline__ unsigned cvt_pk_bf16(float lo, float hi) { unsigned r; asm volatile("v_cvt_pk_bf16_f32 %0, %1, %2" : "=v"(r) : "v"(lo), "v"(hi)); return r; }
__device__ __forceinline__ float rows4_sum(float s) {
    auto a = __builtin_amdgcn_permlane16_swap(__builtin_bit_cast(unsigned, s), __builtin_bit_cast(unsigned, s), false, false);
    const unsigned a0 = a[0], a1 = a[1]; const float t = __builtin_bit_cast(float, a0) + __builtin_bit_cast(float, a1);
    auto b = __builtin_amdgcn_permlane32_swap(__builtin_bit_cast(unsigned, t), __builtin_bit_cast(unsigned, t), false, false);
    const unsigned b0 = b[0], b1 = b[1]; return __builtin_bit_cast(float, b0) + __builtin_bit_cast(float, b1);
}
__device__ __forceinline__ void rows_rstd(float (&rs)[2][4], const float* __restrict__ ssq, int row0, int fq) {
#pragma unroll
    for (int ai = 0; ai < 2; ++ai) {
        f32x4 a[4], b[4];
#pragma unroll
        for (int m = 0; m < 4; ++m) { const float* p = ssq + (size_t)(row0 + ai * HALF + m * 16) * 32 + fq * 8; a[m] = *(const f32x4*)p; b[m] = *(const f32x4*)(p + 4); }
#pragma unroll
        for (int m = 0; m < 4; ++m) { float s = ((a[m][0] + a[m][1]) + (a[m][2] + a[m][3])) + ((b[m][0] + b[m][1]) + (b[m][2] + b[m][3]));
            s += __shfl_xor(s, 16); s += __shfl_xor(s, 32); rs[ai][m] = __builtin_amdgcn_rsqf(s * (1.0f / 2048.0f) + 1e-6f); }
        asm volatile("" ::: "memory");
    }
}
struct RstdCache { int* tag; PG8_LAS float* slot; };
__device__ __forceinline__ void rows_rstd_cached(float (&rs)[2][4], const float* __restrict__ ssq, int row0, int fq, int pm, const RstdCache& c, int lane) {
    PG8_LAS f32x4* p = (PG8_LAS f32x4*)(c.slot + lane * 8);
    if (*c.tag == pm) { const f32x4 a = p[0], b = p[1]; rs[0][0] = a[0]; rs[0][1] = a[1]; rs[0][2] = a[2]; rs[0][3] = a[3]; rs[1][0] = b[0]; rs[1][1] = b[1]; rs[1][2] = b[2]; rs[1][3] = b[3]; }
    else { rows_rstd(rs, ssq, row0, fq); p[0] = (f32x4){rs[0][0], rs[0][1], rs[0][2], rs[0][3]}; p[1] = (f32x4){rs[1][0], rs[1][1], rs[1][2], rs[1][3]}; *c.tag = pm; }
}
struct EpiScaleBf16 {
    static constexpr bool PERM = true, AFTER_DRAIN = false, INIT_ACC = false; static constexpr int NST = 16;
    bf16_t* O; int ldc; const float* ssq; RstdCache rc; int silu_lo, silu_hi;
    __device__ __forceinline__ void operator()(const f32x4 (&acc)[2][2][4][2], const Unit& u, int wr, int wc, int fr, int fq) const {
        const int row0 = u.pm * BM + wr * 64 + fr, col0 = u.pn * BM + wc * 32 + 8 * fq;
        float rs[2][4];
        if (ssq) rows_rstd_cached(rs, ssq, row0, fq, u.pm, rc, fq * 16 + fr);
        else {
#pragma unroll
            for (int ai = 0; ai < 2; ++ai)
#pragma unroll
                for (int m = 0; m < 4; ++m) rs[ai][m] = 1.f; }
        const bool tile_gated = u.pn * BM < silu_hi && u.pn * BM + BM > silu_lo;
        const float qsc = (silu_hi < 0 && u.pn * BM < -silu_hi) ? 0.12751743f : 1.0f;
#pragma unroll
        for (int ai = 0; ai < 2; ++ai)
#pragma unroll
            for (int m = 0; m < 4; ++m) { const int row = row0 + ai * HALF + m * 16; const float r1 = rs[ai][m] * qsc; bf16_t* rowp = O + (size_t)row * ldc + col0;
#pragma unroll
                for (int bj = 0; bj < 2; ++bj) { f32x4 v0 = acc[ai][bj][m][0] * r1, v1 = acc[ai][bj][m][1] * r1;
                    if (tile_gated) { const int c = col0 + bj * HALF; const bool g = c >= silu_lo && c < silu_hi;
#pragma unroll
                        for (int j = 0; j < 4; ++j) { const float a = v0[j], b = v1[j];
                            const float sa = a * __builtin_amdgcn_rcpf(1.0f + __builtin_amdgcn_exp2f(a * -1.4426950408889634f)), sb = b * __builtin_amdgcn_rcpf(1.0f + __builtin_amdgcn_exp2f(b * -1.4426950408889634f));
                            v0[j] = g ? sa : a; v1[j] = g ? sb : b; } }
                    u32x4 w; w.x = cvt_pk_bf16(v0[0], v0[1]); w.y = cvt_pk_bf16(v0[2], v0[3]); w.z = cvt_pk_bf16(v1[0], v1[1]); w.w = cvt_pk_bf16(v1[2], v1[3]);
                    *(u32x4*)(rowp + bj * HALF) = w; } }
    }
};
#ifndef MK_HID_DROP
#define MK_HID_DROP 0
#endif
__device__ __forceinline__ unsigned pk_round_bf16(unsigned w) { constexpr unsigned D = MK_HID_DROP, one = 0x00010001u; return D ? ((w + ((one << (D - 1)) - one) + ((w >> D) & one)) & ~(((one << D) - one))) : w; }
#define HIDQ(x) pk_round_bf16(x)
struct EpiSwiglu {
    static constexpr bool PERM = true, AFTER_DRAIN = false, INIT_ACC = false; static constexpr int NST = 8;
    bf16_t* O; int ldc; const float* ssq; RstdCache rc;
    __device__ __forceinline__ void operator()(const f32x4 (&acc)[2][2][4][2], const Unit& u, int wr, int wc, int fr, int fq) const {
        const int row0 = u.pm * BM + wr * 64 + fr, col0 = u.pn * HALF + wc * 32 + 8 * fq;
        float rs[2][4]; rows_rstd_cached(rs, ssq, row0, fq, u.pm, rc, fq * 16 + fr);
#pragma unroll
        for (int ai = 0; ai < 2; ++ai)
#pragma unroll
            for (int m = 0; m < 4; ++m) { const int row = row0 + ai * HALF + m * 16; const float r1 = rs[ai][m]; bf16_t* rowp = O + (size_t)row * ldc + col0;
                float h[8];
#pragma unroll
                for (int n = 0; n < 2; ++n)
#pragma unroll
                    for (int j = 0; j < 4; ++j) { const float g = acc[ai][0][m][n][j] * r1, up = acc[ai][1][m][n][j] * r1;
                        const float e = __builtin_amdgcn_exp2f(g * -1.4426950408889634f); h[n * 4 + j] = g * __builtin_amdgcn_rcpf(1.0f + e) * up; }
                u32x4 w; w.x = HIDQ(cvt_pk_bf16(h[0], h[1])); w.y = HIDQ(cvt_pk_bf16(h[2], h[3])); w.z = HIDQ(cvt_pk_bf16(h[4], h[5])); w.w = HIDQ(cvt_pk_bf16(h[6], h[7]));
                __builtin_nontemporal_store(w, (u32x4*)rowp); }
    }
};
__device__ __forceinline__ void unpack8(float (&o)[8], const u32x4 q) {
    const unsigned a = q.x, b = q.y, c = q.z, d = q.w;
    o[0] = __builtin_bit_cast(float, a << 16); o[1] = __builtin_bit_cast(float, a & 0xffff0000u); o[2] = __builtin_bit_cast(float, b << 16); o[3] = __builtin_bit_cast(float, b & 0xffff0000u);
    o[4] = __builtin_bit_cast(float, c << 16); o[5] = __builtin_bit_cast(float, c & 0xffff0000u); o[6] = __builtin_bit_cast(float, d << 16); o[7] = __builtin_bit_cast(float, d & 0xffff0000u);
}
struct EpiRes {
    static constexpr bool PERM = true, AFTER_DRAIN = false, INIT_ACC = false; static constexpr int NST = 16;
    const bf16_t* base; bf16_t* hb; int ldc; float* ssq_out; unsigned char* h8;
    __device__ __forceinline__ void operator()(const f32x4 (&acc)[2][2][4][2], const Unit& u, int wr, int wc, int fr, int fq) const {
        const int row0 = u.pm * BM + wr * 64 + fr, col0 = u.pn * BM + wc * 32 + 8 * fq;
#pragma unroll
        for (int ai = 0; ai < 2; ++ai) {
            u32x4 bs[4][2];
#pragma unroll
            for (int m = 0; m < 4; ++m)
#pragma unroll
                for (int bj = 0; bj < 2; ++bj) bs[m][bj] = *(const u32x4*)(base + (size_t)(row0 + ai * HALF + m * 16) * ldc + col0 + bj * HALF);
            asm volatile("" ::: "memory");
#pragma unroll
            for (int m = 0; m < 4; ++m) { const int row = row0 + ai * HALF + m * 16; const size_t off = (size_t)row * ldc + col0; float ss = 0.f;
#pragma unroll
                for (int bj = 0; bj < 2; ++bj) { float o[8]; unpack8(o, bs[m][bj]);
#pragma unroll
                    for (int j = 0; j < 4; ++j) { o[j] += acc[ai][bj][m][0][j]; o[4 + j] += acc[ai][bj][m][1][j]; }
#pragma unroll
                    for (int j = 0; j < 8; ++j) ss += o[j] * o[j];
                    u32x4 w; w.x = cvt_pk_bf16(o[0], o[1]); w.y = cvt_pk_bf16(o[2], o[3]); w.z = cvt_pk_bf16(o[4], o[5]); w.w = cvt_pk_bf16(o[6], o[7]); *(u32x4*)(hb + off + bj * HALF) = w;
                    if (h8) { float c8[8];
#pragma unroll
                        for (int j = 0; j < 8; ++j) c8[j] = __builtin_amdgcn_fmed3f(o[j], -448.f, 448.f);
                        int q0 = __builtin_amdgcn_cvt_pk_fp8_f32(c8[0], c8[1], 0, false); q0 = __builtin_amdgcn_cvt_pk_fp8_f32(c8[2], c8[3], q0, true); int q1 = __builtin_amdgcn_cvt_pk_fp8_f32(c8[4], c8[5], 0, false); q1 = __builtin_amdgcn_cvt_pk_fp8_f32(c8[6], c8[7], q1, true);
                        u32x2 w8; w8.x = (unsigned)q0; w8.y = (unsigned)q1; *(u32x2*)(h8 + off + bj * HALF) = w8; } }
                ss += __shfl_xor(ss, 16); ss += __shfl_xor(ss, 32);
                if (fq == 0) ssq_out[(size_t)row * 32 + u.pn * 4 + wc] = ss; }
            asm volatile("" ::: "memory");
        }
    }
};
struct EpiGate8 {
    static constexpr bool PERM = true, AFTER_DRAIN = false, INIT_ACC = false; static constexpr int NST = 16;
    unsigned char* S; int ldc; const float* ssq; float gs;
    __device__ __forceinline__ void operator()(const f32x4 (&acc)[2][2][4][2], const Unit& u, int wr, int wc, int fr, int fq) const {
        const int row0 = u.pm * BM + wr * 64 + fr, col0 = u.pn * BM + wc * 32 + 8 * fq;
        float rs[2][4]; rows_rstd(rs, ssq, row0, fq);
#pragma unroll
        for (int ai = 0; ai < 2; ++ai)
#pragma unroll
            for (int m = 0; m < 4; ++m) { const int row = row0 + ai * HALF + m * 16; const float r1 = rs[ai][m] * gs * -1.4426950408889634f;
#pragma unroll
                for (int bj = 0; bj < 2; ++bj) { unsigned q[2];
#pragma unroll
                    for (int n = 0; n < 2; ++n) { unsigned w = 0u;
#pragma unroll
                        for (int j = 0; j < 4; ++j) { const float s = __builtin_amdgcn_rcpf(1.0f + __builtin_amdgcn_exp2f(acc[ai][bj][m][n][j] * r1)); w = __builtin_amdgcn_cvt_pk_u8_f32(__builtin_rintf(s * 255.0f), j, w); }
                        q[n] = w; }
                    u32x2 w8; w8.x = q[0]; w8.y = q[1]; *(u32x2*)(S + (size_t)row * ldc + col0 + bj * HALF) = w8; } }
    }
};
struct EpiPeComb {
    static constexpr bool PERM = true, AFTER_DRAIN = false, INIT_ACC = false; static constexpr int NST = 16;
    bf16_t* hb; const unsigned char* S; int ldc; float* ssq_out;
    __device__ __forceinline__ void operator()(const f32x4 (&acc)[2][2][4][2], const Unit& u, int wr, int wc, int fr, int fq) const {
        const int row0 = u.pm * BM + wr * 64 + fr, col0 = u.pn * BM + wc * 32 + 8 * fq;
#pragma unroll
        for (int ai = 0; ai < 2; ++ai) {
            u32x4 hq[4][2]; u32x2 sq[4][2];
#pragma unroll
            for (int m = 0; m < 4; ++m)
#pragma unroll
                for (int bj = 0; bj < 2; ++bj) { const size_t o2 = (size_t)(row0 + ai * HALF + m * 16) * ldc + col0 + bj * HALF; hq[m][bj] = *(const u32x4*)(hb + o2); sq[m][bj] = *(const u32x2*)(S + o2); }
            asm volatile("" ::: "memory");
#pragma unroll
            for (int m = 0; m < 4; ++m) { const int row = row0 + ai * HALF + m * 16; float ss = 0.f;
#pragma unroll
                for (int bj = 0; bj < 2; ++bj) { float o[8]; unpack8(o, hq[m][bj]);
#pragma unroll
                    for (int j = 0; j < 8; ++j) { const unsigned wq = j < 4 ? sq[m][bj].x : sq[m][bj].y; const float s = (float)((wq >> (8 * (j & 3))) & 0xffu) * (1.0f / 255.0f);
                        o[j] = fmaf(acc[ai][bj][m][j >> 2][j & 3], s, o[j]); ss += o[j] * o[j]; }
                    u32x4 w; w.x = cvt_pk_bf16(o[0], o[1]); w.y = cvt_pk_bf16(o[2], o[3]); w.z = cvt_pk_bf16(o[4], o[5]); w.w = cvt_pk_bf16(o[6], o[7]); *(u32x4*)(hb + (size_t)row * ldc + col0 + bj * HALF) = w; }
                ss += __shfl_xor(ss, 16); ss += __shfl_xor(ss, 32);
                if (fq == 0) ssq_out[(size_t)row * 32 + u.pn * 4 + wc] = ss; }
            asm volatile("" ::: "memory");
        }
    }
};
struct EpiPle {
    static constexpr bool PERM = true, AFTER_DRAIN = false, INIT_ACC = false; static constexpr int NST = 16;
    const bf16_t* h; bf16_t* pe; int ldc; const float* ssq; float* ssq_out; RstdCache rc; float gs;
    __device__ __forceinline__ void operator()(const f32x4 (&acc)[2][2][4][2], const Unit& u, int wr, int wc, int fr, int fq) const {
        const int row0 = u.pm * BM + wr * 64 + fr, col0 = u.pn * BM + wc * 32 + 8 * fq;
#pragma unroll
        for (int ai = 0; ai < 2; ++ai)
#pragma unroll
            for (int mh = 0; mh < 2; ++mh) {
                f32x4 ra[2], rb[2]; u32x4 hq[2][2], pq[2][2]; unsigned ob[2];
#pragma unroll
                for (int m2 = 0; m2 < 2; ++m2) { const int row = row0 + ai * HALF + (2 * mh + m2) * 16;
                    const unsigned os_ = ((unsigned)row * 32u + fq * 8u) * 4u; ra[m2] = *(const f32x4*)((const char*)ssq + os_); rb[m2] = *(const f32x4*)((const char*)ssq + os_ + 16u);
                    unsigned ob_ = ((unsigned)row * (unsigned)ldc + col0) * 2u; asm volatile("" : "+v"(ob_)); ob[m2] = ob_;
#pragma unroll
                    for (int bj = 0; bj < 2; ++bj) { hq[m2][bj] = *(const u32x4*)((const char*)h + ob_ + bj * (HALF * 2)); pq[m2][bj] = *(const u32x4*)((const char*)pe + ob_ + bj * (HALF * 2)); } }
                asm volatile("" ::: "memory");
#pragma unroll
                for (int m2 = 0; m2 < 2; ++m2) { const int m = 2 * mh + m2, row = row0 + ai * HALF + m * 16;
                    float s = ((ra[m2][0] + ra[m2][1]) + (ra[m2][2] + ra[m2][3])) + ((rb[m2][0] + rb[m2][1]) + (rb[m2][2] + rb[m2][3]));
                    s = rows4_sum(s); const float r1 = __builtin_amdgcn_rsqf(s * (1.0f / 2048.0f) + 1e-6f) * gs; float ss = 0.f;
#pragma unroll
                    for (int bj = 0; bj < 2; ++bj) { float hv[8], pv[8], o[8]; unpack8(hv, hq[m2][bj]); unpack8(pv, pq[m2][bj]);
#pragma unroll
                        for (int j = 0; j < 8; ++j) { const float a = acc[ai][bj][m][j >> 2][j & 3] * r1; const float e2 = __builtin_amdgcn_exp2f(a * -1.4426950408889634f); o[j] = hv[j] + pv[j] * __builtin_amdgcn_rcpf(1.0f + e2); ss += o[j] * o[j]; }
                        u32x4 w; w.x = cvt_pk_bf16(o[0], o[1]); w.y = cvt_pk_bf16(o[2], o[3]); w.z = cvt_pk_bf16(o[4], o[5]); w.w = cvt_pk_bf16(o[6], o[7]); *(u32x4*)((char*)pe + ob[m2] + bj * (HALF * 2)) = w; }
                    ss = rows4_sum(ss);
                    if (fq == 0) *(float*)((char*)ssq_out + ((unsigned)row * 32u + u.pn * 4 + wc) * 4u) = ss; }
                asm volatile("" ::: "memory");
            }
    }
};
template <class Epi, class Sched, bool ALIGN_EPI = false, bool SP2 = false, bool F8 = false>
__device__ __forceinline__ void gemm_phase(PG8_LAS unsigned char* lds, const Gemm g, const Sched& S, const Epi& E) {
    int tid_ = threadIdx.x; asm volatile("" : "+v"(tid_));
    const int tid = tid_, wid = __builtin_amdgcn_readfirstlane(tid >> 6), lane = tid & 63, wr = wid >> 2, wc = wid & 3, fr = lane & 15, fq = lane >> 4;
    const int K = g.K, nt = K / BK;
    unsigned voffA[2], voffB[2];
#pragma unroll
    for (int i = 0; i < 2; ++i) { int R, C; stage_rc(tid * 16 + i * 8192, R, C); const int Rb = Epi::PERM ? ((R & ~31) + perm32(R & 31)) : R;
        voffA[i] = (unsigned)(R * K + C) * 2u; voffB[i] = (unsigned)(Rb * K + C) * 2u; }
    const size_t kstep = (size_t)(BK * 2);
    const size_t hstep = (size_t)HALF * K * 2;
    const size_t tstep = 2 * hstep;
    const unsigned ldsw = (unsigned)wid * 1024u;
    const int aoff = lds_byte(wr * 64 + fr, fq * 8), boff = lds_byte(wc * 32 + fr, fq * 8);
#define PG8_SA(b, h) (((b) * 2 + (h)) * HTB)
#define PG8_SB(b, h) ((4 + (b) * 2 + (h)) * HTB)
#define PG8_STAGE(bufoff, gbase, voff) do { _Pragma("unroll") for (int _i = 0; _i < 2; ++_i) { unsigned vo_ = (voff)[_i]; if constexpr (F8) asm volatile("" : "+v"(vo_));     \
        __builtin_amdgcn_global_load_lds((const unsigned*)((const char*)(gbase) + vo_), (PG8_LAS unsigned*)(lds + (bufoff) + ldsw + _i * 8192), 16, 0, 0); } } while (0)
#define PG8_LDA(dst, b, h) do { _Pragma("unroll") for (int m = 0; m < 4; ++m) _Pragma("unroll") for (int k = 0; k < 2; ++k) dst[m][k] = *(const PG8_LAS bf16x8*)(lds + PG8_SA(b, h) + aoff + m * 2048 + k * 1024); } while (0)
#define PG8_LDB(dst, b, h) do { _Pragma("unroll") for (int n = 0; n < 2; ++n) _Pragma("unroll") for (int k = 0; k < 2; ++k) dst[n][k] = *(const PG8_LAS bf16x8*)(lds + PG8_SB(b, h) + boff + n * 2048 + k * 1024); } while (0)
#define PG8_MMA(ai, bj, At, Bt) do { __builtin_amdgcn_s_setprio(1); _Pragma("unroll") for (int m = 0; m < 4; ++m) _Pragma("unroll") for (int n = 0; n < 2; ++n) _Pragma("unroll") for (int k = 0; k < 2; ++k) \
        acc[ai][bj][m][n] = __builtin_amdgcn_mfma_f32_16x16x32_bf16(Bt[n][k], At[m][k], acc[ai][bj][m][n], 0, 0, 0); __builtin_amdgcn_s_setprio(0); } while (0)
#define PG8_LD8(dst, base, off) do { const v4i_t lo_ = *(const PG8_LAS v4i_t*)((base) + (off)), hi_ = *(const PG8_LAS v4i_t*)((base) + (off) + 1024); dst = __builtin_shufflevector(lo_, hi_, 0, 1, 2, 3, 4, 5, 6, 7); } while (0)
#define PG8_LDA8(dst, b, h, m) PG8_LD8(dst, la8, PG8_SA(b, h) + (m) * 2048)
#define PG8_LDB8(dst, b, h) do { PG8_LD8(dst[0], lb8, PG8_SB(b, h) - 4 * HTB); PG8_LD8(dst[1], lb8, PG8_SB(b, h) - 4 * HTB + 2048); } while (0)
#define PG8_MF8(ai, bj, m, n, A8) acc[ai][bj][m][n] = __builtin_amdgcn_mfma_scale_f32_16x16x128_f8f6f4((bj) ? Bq1[n] : Bq0[n], A8, acc[ai][bj][m][n], 0, 0, 0, 0, 0, 0)
#define PG8_MMA8(ai, m, A8) do { PG8_MF8(ai, 0, m, 0, A8); PG8_MF8(ai, 1, m, 0, A8); PG8_MF8(ai, 0, m, 1, A8); PG8_MF8(ai, 1, m, 1, A8); } while (0)
#define PG8_MMA8R(ai, m, A8) do { PG8_MF8(ai, 1, m, 0, A8); PG8_MF8(ai, 0, m, 1, A8); PG8_MF8(ai, 1, m, 1, A8); } while (0)
#define PG8_BLOCK8(ai, b, h) do { __builtin_amdgcn_s_setprio(1); \
        PG8_MMA8(ai, 0, Aq0); PG8_SCHED; \
        PG8_MF8(ai, 0, 1, 0, Aq1); PG8_SCHED; PG8_LDA8(Aq0, b, h, 2); PG8_SCHED; PG8_MMA8R(ai, 1, Aq1); PG8_SCHED; \
        PG8_MF8(ai, 0, 2, 0, Aq0); PG8_SCHED; PG8_LDA8(Aq1, b, h, 3); PG8_SCHED; PG8_MMA8R(ai, 2, Aq0); PG8_SCHED; \
        PG8_MMA8(ai, 3, Aq1); __builtin_amdgcn_s_setprio(0); } while (0)
#define PG8_WAIT_V(n) asm volatile("s_waitcnt vmcnt(" #n ")" ::: "memory")
#define PG8_WAIT_L(n) asm volatile("s_waitcnt lgkmcnt(" #n ")" ::: "memory")
#define PG8_BAR __builtin_amdgcn_s_barrier()
#define PG8_SCHED __builtin_amdgcn_sched_barrier(0)
    Unit cur, nxt; int ui = 0;
    if (!S.next(0, cur)) return;
    f32x4 acc[2][2][4][2];
    if constexpr (Epi::INIT_ACC) E.init(acc, cur, wr, wc, fr, fq);
    else {
#pragma unroll
    for (int a = 0; a < 2; ++a)
#pragma unroll
        for (int b = 0; b < 2; ++b)
#pragma unroll
            for (int m = 0; m < 4; ++m)
#pragma unroll
                for (int n = 0; n < 2; ++n) acc[a][b][m][n] = (f32x4){0.f, 0.f, 0.f, 0.f};
    }
    bf16x8 At[4][2], B0[2][2], B1[2][2]; v8i_t Aq0, Aq1, Bq0[2], Bq1[2]; (void)Aq0; (void)Aq1; (void)Bq0; (void)Bq1;
    const char* cA = (const char*)g.A + (size_t)cur.pm * tstep; const char* cB = (const char*)g.Bt + (size_t)cur.pn * tstep;
    S.a_ready(cur);
    if constexpr (SP2) {
        PG8_STAGE(PG8_SB(0, 0), cB, voffB); PG8_STAGE(PG8_SB(0, 1), cB + hstep, voffB); PG8_STAGE(PG8_SA(0, 0), cA, voffA); PG8_STAGE(PG8_SA(0, 1), cA + hstep, voffA);
        if (wr == 1) PG8_BAR;
        PG8_WAIT_V(2); PG8_BAR;
        PG8_STAGE(PG8_SB(1, 0), cB + kstep, voffB); PG8_STAGE(PG8_SA(1, 0), cA + kstep, voffA); PG8_STAGE(PG8_SB(1, 1), cB + hstep + kstep, voffB);
        PG8_WAIT_V(6); PG8_BAR;
    } else {
        PG8_STAGE(PG8_SB(0, 0), cB, voffB); PG8_STAGE(PG8_SA(0, 0), cA, voffA); PG8_STAGE(PG8_SB(0, 1), cB + hstep, voffB); PG8_STAGE(PG8_SA(0, 1), cA + hstep, voffA);
        if (wr == 1) PG8_BAR;
        PG8_WAIT_V(4); PG8_BAR;
        PG8_STAGE(PG8_SB(1, 0), cB + kstep, voffB); PG8_STAGE(PG8_SA(1, 0), cA + kstep, voffA); PG8_STAGE(PG8_SB(1, 1), cB + hstep + kstep, voffB);
        PG8_WAIT_V(6); PG8_BAR;
    }
#if MK_GEMM_PROF
    unsigned long long gp_t = __builtin_amdgcn_s_memrealtime();
#define GP_ACC(k) do { if (tid == 0) { const unsigned long long t1_ = __builtin_amdgcn_s_memrealtime(); ((volatile PG8_LAS unsigned*)(lds + MISC_OFF))[k] += (unsigned)(t1_ - gp_t); gp_t = t1_; } } while (0)
#else
#define GP_ACC(k) do { } while (0)
#endif
    GP_ACC(22);
    for (;;) {
        const bool has_next = S.next(ui + 1, nxt);
        const char* nA = has_next ? (const char*)g.A + (size_t)nxt.pm * tstep : cA; const char* nB = has_next ? (const char*)g.Bt + (size_t)nxt.pn * tstep : cB;
        for (int t = 0; t < nt; t += 2) {
            const bool last = (t == nt - 2);
            const char* a1 = cA + (size_t)(t + 1) * kstep;
            const char* a2 = last ? nA : cA + (size_t)(t + 2) * kstep; const char* b2 = last ? nB : cB + (size_t)(t + 2) * kstep;
            const char* a3 = a2 + kstep; const char* b3 = b2 + kstep;
            if (last && has_next) S.a_ready(nxt);
            if constexpr (F8) {
            PG8_LAS unsigned char* la8 = lds + aoff; PG8_LAS unsigned char* lb8 = lds + 4 * HTB + boff; asm volatile("" : "+v"(la8), "+v"(lb8));
            PG8_LDB8(Bq0, 0, 0); PG8_LDB8(Bq1, 0, 1); PG8_SCHED; PG8_LDA8(Aq0, 0, 0, 0); PG8_LDA8(Aq1, 0, 0, 1); PG8_STAGE(PG8_SA(1, 1), a1 + hstep, voffA);
            PG8_WAIT_V(8); PG8_WAIT_L(0); PG8_BAR; PG8_BLOCK8(0, 0, 0); PG8_BAR; PG8_SCHED;
            PG8_LDA8(Aq0, 0, 1, 0); PG8_LDA8(Aq1, 0, 1, 1); PG8_STAGE(PG8_SB(0, 0), b2, voffB); PG8_STAGE(PG8_SB(0, 1), b2 + hstep, voffB); PG8_STAGE(PG8_SA(0, 0), a2, voffA);
            PG8_WAIT_V(8); PG8_WAIT_L(0); PG8_BAR; PG8_BLOCK8(1, 0, 1); PG8_BAR; PG8_SCHED;
            PG8_LDB8(Bq0, 1, 0); PG8_LDB8(Bq1, 1, 1); PG8_SCHED; PG8_LDA8(Aq0, 1, 0, 0); PG8_LDA8(Aq1, 1, 0, 1); PG8_STAGE(PG8_SA(0, 1), a2 + hstep, voffA);
            PG8_WAIT_V(8); PG8_WAIT_L(0); PG8_BAR; PG8_BLOCK8(0, 1, 0); PG8_BAR; PG8_SCHED;
            PG8_LDA8(Aq0, 1, 1, 0); PG8_LDA8(Aq1, 1, 1, 1); PG8_STAGE(PG8_SB(1, 0), b3, voffB); PG8_STAGE(PG8_SB(1, 1), b3 + hstep, voffB); PG8_STAGE(PG8_SA(1, 0), a3, voffA);
            PG8_WAIT_V(8); PG8_WAIT_L(0); PG8_BAR; PG8_BLOCK8(1, 1, 1); PG8_BAR; PG8_SCHED;
            } else if constexpr (SP2) {
            PG8_LDB(B0, 0, 0); PG8_LDB(B1, 0, 1); PG8_SCHED; PG8_LDA(At, 0, 0); PG8_STAGE(PG8_SA(1, 1), a1 + hstep, voffA);
            PG8_WAIT_V(8); PG8_WAIT_L(0); PG8_BAR; PG8_MMA(0, 0, At, B0); PG8_MMA(0, 1, At, B1); PG8_BAR; PG8_SCHED;
            PG8_LDA(At, 0, 1); PG8_STAGE(PG8_SB(0, 0), b2, voffB); PG8_STAGE(PG8_SB(0, 1), b2 + hstep, voffB); PG8_STAGE(PG8_SA(0, 0), a2, voffA);
            PG8_WAIT_V(8); PG8_WAIT_L(0); PG8_BAR; PG8_MMA(1, 0, At, B0); PG8_MMA(1, 1, At, B1); PG8_BAR; PG8_SCHED;
            PG8_LDB(B0, 1, 0); PG8_LDB(B1, 1, 1); PG8_SCHED; PG8_LDA(At, 1, 0); PG8_STAGE(PG8_SA(0, 1), a2 + hstep, voffA);
            PG8_WAIT_V(8); PG8_WAIT_L(0); PG8_BAR; PG8_MMA(0, 0, At, B0); PG8_MMA(0, 1, At, B1); PG8_BAR; PG8_SCHED;
            PG8_LDA(At, 1, 1); PG8_STAGE(PG8_SB(1, 0), b3, voffB); PG8_STAGE(PG8_SB(1, 1), b3 + hstep, voffB); PG8_STAGE(PG8_SA(1, 0), a3, voffA);
            PG8_WAIT_V(8); PG8_WAIT_L(0); PG8_BAR; PG8_MMA(1, 0, At, B0); PG8_MMA(1, 1, At, B1); PG8_BAR; PG8_SCHED;
            } else {
            PG8_LDB(B0, 0, 0); PG8_SCHED; PG8_LDA(At, 0, 0); PG8_STAGE(PG8_SA(1, 1), a1 + hstep, voffA);
            PG8_WAIT_L(8); PG8_BAR; PG8_WAIT_L(0); PG8_MMA(0, 0, At, B0); PG8_BAR; PG8_SCHED;
            PG8_LDB(B1, 0, 1); PG8_STAGE(PG8_SB(0, 0), b2, voffB);
            PG8_BAR; PG8_WAIT_L(0); PG8_MMA(0, 1, At, B1); PG8_BAR;
            PG8_LDA(At, 0, 1); PG8_STAGE(PG8_SA(0, 0), a2, voffA);
            PG8_BAR; PG8_WAIT_L(0); PG8_MMA(1, 0, At, B0); PG8_BAR; PG8_SCHED;
            PG8_STAGE(PG8_SB(0, 1), b2 + hstep, voffB);
            PG8_WAIT_V(6); PG8_BAR; PG8_MMA(1, 1, At, B1); PG8_BAR;
            PG8_LDB(B0, 1, 0); PG8_SCHED; PG8_LDA(At, 1, 0); PG8_STAGE(PG8_SA(0, 1), a2 + hstep, voffA);
            PG8_WAIT_L(8); PG8_BAR; PG8_WAIT_L(0); PG8_MMA(0, 0, At, B0); PG8_BAR; PG8_SCHED;
            PG8_LDB(B1, 1, 1); PG8_STAGE(PG8_SB(1, 0), b3, voffB);
            PG8_BAR; PG8_WAIT_L(0); PG8_MMA(0, 1, At, B1); PG8_BAR;
            PG8_LDA(At, 1, 1); PG8_STAGE(PG8_SA(1, 0), a3, voffA);
            PG8_BAR; PG8_WAIT_L(0); PG8_MMA(1, 0, At, B0); PG8_BAR; PG8_SCHED;
            PG8_STAGE(PG8_SB(1, 1), b3 + hstep, voffB);
            PG8_WAIT_V(6); PG8_BAR; PG8_MMA(1, 1, At, B1); PG8_BAR;
            }
        }
        GP_ACC(20);
        if constexpr (ALIGN_EPI) { if (wr == 0) PG8_BAR; }
        if constexpr (!Epi::AFTER_DRAIN) { int te_ = threadIdx.x; asm volatile("" : "+v"(te_)); const int fr_ = te_ & 15, fq_ = (te_ >> 4) & 3;
            E(acc, cur, wr, wc, fr_, fq_); S.done(cur); }
        GP_ACC(21);
        if (!has_next) break;
        if constexpr (Epi::INIT_ACC) E.init(acc, nxt, wr, wc, fr, fq);
        else {
#pragma unroll
        for (int a = 0; a < 2; ++a)
#pragma unroll
            for (int b = 0; b < 2; ++b)
#pragma unroll
                for (int m = 0; m < 4; ++m)
#pragma unroll
                    for (int n = 0; n < 2; ++n) acc[a][b][m][n] = (f32x4){0.f, 0.f, 0.f, 0.f};
        }
        cur = nxt; cA = nA; cB = nB; ++ui;
        if constexpr (ALIGN_EPI) { if (wr == 1) PG8_BAR; }
    }
    PG8_WAIT_V(0);
    if constexpr (!ALIGN_EPI) { if (wr == 0) PG8_BAR; }
    PG8_BAR;
    if constexpr (Epi::AFTER_DRAIN) { E.fused(acc, cur, wr, wc, fr, fq, lds, wid, lane); S.done(cur); }
#undef GP_ACC
#undef PG8_SA
#undef PG8_SB
#undef PG8_STAGE
#undef PG8_LDA
#undef PG8_LDB
#undef PG8_MMA
#undef PG8_LD8
#undef PG8_LDA8
#undef PG8_LDB8
#undef PG8_MMA8
#undef PG8_MMA8R
#undef PG8_MF8
#undef PG8_BLOCK8
#undef PG8_WAIT_V
#undef PG8_WAIT_L
#undef PG8_BAR
#undef PG8_SCHED
}
}
#define XB_TMO      128
#define XB_XCNT(j)  (256  + 64 * (j))
#define XB_XSUB(j)  (1280 + 64 * (j))
#define XB_XGEN(j)  (2304 + 64 * (j))
#define XB_TOP      3328
#define XB_TOPGEN   3392
#define XCD_BAR_WORDS 3456
#define XB_SPIN_CAP (1u << 18)

__device__ __forceinline__ unsigned xb_ld(unsigned* p)              { return __hip_atomic_load(p, __ATOMIC_RELAXED, __HIP_MEMORY_SCOPE_AGENT); }
__device__ __forceinline__ unsigned xb_add(unsigned* p, unsigned v) { return __hip_atomic_fetch_add(p, v, __ATOMIC_RELAXED, __HIP_MEMORY_SCOPE_AGENT); }
__device__ __forceinline__ unsigned xb_xcc_id() { return (unsigned)__builtin_amdgcn_s_getreg((3 << 11) | 20) & 0xFu; }
#define XB_SPIN(cond, bar) do { unsigned _sp = 0; while (cond) { __builtin_amdgcn_s_sleep(1); \
    if ((++_sp & 255u) == 0u) { if (xb_ld(&(bar)[XB_TMO])) break; if (_sp > XB_SPIN_CAP) { atomicAdd(&(bar)[XB_TMO], 1u); break; } } } } while (0)

struct XcdBarrier {
    unsigned* bar; unsigned x;
    volatile LAS unsigned* st;
};

__device__ __forceinline__ XcdBarrier xcd_barrier_post(unsigned* bar, volatile LAS unsigned* st) {
    XcdBarrier b; b.bar = bar; b.x = xb_xcc_id(); b.st = st;
    if (threadIdx.x == 0) (void)xb_add(&bar[XB_XCNT(b.x)], 1u);
    return b;
}
__device__ __forceinline__ void xcd_barrier_complete(unsigned* bar, unsigned x, unsigned& nloc, unsigned& nx) {
    const unsigned G = gridDim.x * gridDim.y * gridDim.z;
    unsigned sum, cnt, mine, sp = 0u;
    for (;;) {
        sum = 0u; cnt = 0u; mine = 0u;
#pragma unroll
        for (unsigned j = 0; j < 16; ++j) { const unsigned c = xb_ld(&bar[XB_XCNT(j)]); sum += c; cnt += (c > 0u) ? 1u : 0u; mine = (j == x) ? c : mine; }
        if (sum == G) break;
        __builtin_amdgcn_s_sleep(1);
        if ((++sp & 255u) == 0u) { if (xb_ld(&bar[XB_TMO])) break; if (sp > XB_SPIN_CAP) { atomicAdd(&bar[XB_TMO], 1u); break; } }
    }
    nloc = mine > 0u ? mine : 1u; nx = cnt > 0u ? cnt : 1u;
}

__device__ __forceinline__ void xcd_barrier(const XcdBarrier& b) {
    asm volatile("s_waitcnt vmcnt(0)" ::: "memory");
    __syncthreads();
    if (threadIdx.x == 0) {
        unsigned* bar = b.bar;
        __builtin_amdgcn_s_waitcnt(0);
        unsigned nloc = b.st[0], nx = b.st[1];
        if (nloc == 0u) { xcd_barrier_complete(bar, b.x, nloc, nx); b.st[0] = nloc; b.st[1] = nx; }
        const unsigned old = xb_add(&bar[XB_XSUB(b.x)], 1u);
        const unsigned gen = old / nloc;
        if (old + 1u == (gen + 1u) * nloc) {
            __builtin_amdgcn_fence(__ATOMIC_RELEASE, "agent");
            asm volatile("s_waitcnt vmcnt(0)" ::: "memory");
            const unsigned og = xb_add(&bar[XB_TOP], 1u);
            const unsigned tg = og / nx;
            if (og + 1u == (tg + 1u) * nx) xb_add(&bar[XB_TOPGEN], 1u);
            else XB_SPIN(xb_ld(&bar[XB_TOPGEN]) == tg, bar);
            __builtin_amdgcn_fence(__ATOMIC_ACQUIRE, "agent");
            xb_add(&bar[XB_XGEN(b.x)], 1u);
            asm volatile("s_waitcnt vmcnt(0)" ::: "memory");
        } else {
            XB_SPIN(xb_ld(&bar[XB_XGEN(b.x)]) == gen, bar);
            __builtin_amdgcn_fence(__ATOMIC_ACQUIRE, "agent");
            asm volatile("s_waitcnt vmcnt(0)" ::: "memory");
        }
    }
    __syncthreads();
}
struct Frame {
    LAS unsigned char* lds;
    volatile LAS unsigned* MISC;
    gu32* ctl;
    int tid, lane, wave, vcu, G;
    const float* in[19]; float* out; unsigned char* ws;
};
__device__ __forceinline__ float wave_sum(float v) {
#pragma unroll
    for (int o = 1; o < 64; o <<= 1) v += __shfl_xor(v, o);
    return v;
}
#ifndef MK_NORM_ROWS
#define MK_NORM_ROWS 2
#endif
#ifndef MK_WBITS_DROP
#define MK_WBITS_DROP 2
#endif
__device__ __forceinline__ unsigned f2bfq(float f) { constexpr int S = 16 + MK_WBITS_DROP; unsigned u = __builtin_bit_cast(unsigned, f); return ((u + ((1u << (S - 1)) - 1u) + ((u >> S) & 1u)) >> S) << MK_WBITS_DROP; }
#define WPK2(a, b) (MK_WBITS_DROP ? (f2bfq(a) | (f2bfq(b) << 16)) : pk2(a, b))
__device__ __forceinline__ void p0_item(const float* W, int ldw, int k0, int n0, const float* gain, bf16* WT, int ldk, int drow0, LAS float* scr, int lane, bool full = false) {
    f32x4 v[8]; float gk[8];
#pragma unroll
    for (int i = 0; i < 8; ++i) { const int kk = 8 * i + (lane >> 3); v[i] = __builtin_nontemporal_load((const GAS f32x4*)(W + (size_t)(k0 + kk) * ldw + n0 + 4 * (lane & 7))); gk[i] = gain ? gain[k0 + kk] : 1.f; }
#pragma unroll
    for (int i = 0; i < 8; ++i) { const int kk = 8 * i + (lane >> 3); LAS float* d = scr + kk * 33 + 4 * (lane & 7); d[0] = v[i].x * gk[i]; d[1] = v[i].y * gk[i]; d[2] = v[i].z * gk[i]; d[3] = v[i].w * gk[i]; }
    LDS_WAIT(); asm volatile("" ::: "memory");
    const int c = lane & 7;
#pragma unroll
    for (int j = 0; j < 4; ++j) { const int n = (lane >> 3) + 8 * j; const LAS float* s = scr + (8 * c) * 33 + n;
        v4u o; if (full) { o.x = pk2(s[0 * 33], s[1 * 33]); o.y = pk2(s[2 * 33], s[3 * 33]); o.z = pk2(s[4 * 33], s[5 * 33]); o.w = pk2(s[6 * 33], s[7 * 33]); }
        else { o.x = WPK2(s[0 * 33], s[1 * 33]); o.y = WPK2(s[2 * 33], s[3 * 33]); o.z = WPK2(s[4 * 33], s[5 * 33]); o.w = WPK2(s[6 * 33], s[7 * 33]); }
        *(GAS v4u*)(WT + (size_t)(drow0 + n) * ldk + k0 + 8 * c) = o; }
    LDS_WAIT(); asm volatile("" ::: "memory");
}
__device__ __forceinline__ void p0_item8(const float* W, int ldw, int k0, int n0, const float* gain, unsigned char* WT8, int ldk, int drow0, LAS float* scr, int lane) {
    f32x4 v[8]; float gk[8];
#pragma unroll
    for (int i = 0; i < 8; ++i) { const int kk = 8 * i + (lane >> 3); v[i] = __builtin_nontemporal_load((const GAS f32x4*)(W + (size_t)(k0 + kk) * ldw + n0 + 4 * (lane & 7))); gk[i] = (gain ? gain[k0 + kk] : 1.f) * 64.f; }
#pragma unroll
    for (int i = 0; i < 8; ++i) { const int kk = 8 * i + (lane >> 3); LAS float* d = scr + kk * 33 + 4 * (lane & 7);
        d[0] = __builtin_amdgcn_fmed3f(v[i].x * gk[i], -448.f, 448.f); d[1] = __builtin_amdgcn_fmed3f(v[i].y * gk[i], -448.f, 448.f); d[2] = __builtin_amdgcn_fmed3f(v[i].z * gk[i], -448.f, 448.f); d[3] = __builtin_amdgcn_fmed3f(v[i].w * gk[i], -448.f, 448.f); }
    LDS_WAIT(); asm volatile("" ::: "memory");
    const int c = lane & 7;
#pragma unroll
    for (int j = 0; j < 4; ++j) { const int n = (lane >> 3) + 8 * j; const LAS float* s = scr + (8 * c) * 33 + n;
        int q0 = __builtin_amdgcn_cvt_pk_fp8_f32(s[0 * 33], s[1 * 33], 0, false); q0 = __builtin_amdgcn_cvt_pk_fp8_f32(s[2 * 33], s[3 * 33], q0, true);
        int q1 = __builtin_amdgcn_cvt_pk_fp8_f32(s[4 * 33], s[5 * 33], 0, false); q1 = __builtin_amdgcn_cvt_pk_fp8_f32(s[6 * 33], s[7 * 33], q1, true);
        v2u o; o.x = (unsigned)q0; o.y = (unsigned)q1; *(GAS v2u*)(WT8 + (size_t)(drow0 + n) * ldk + k0 + 8 * c) = o; }
    LDS_WAIT(); asm volatile("" ::: "memory");
}
__device__ __forceinline__ void p0_matrix_item(const float* W, int K, int N, const float* gain, bf16* WT, int mode, int item, LAS float* scr, int lane, bool full = false) {
    const int nblk = N / 32, kb = item / nblk, nb = item % nblk, n0 = 32 * nb;
    const int drow0 = mode == 0 ? n0 : (256 * (n0 >> 7) + (n0 & 127) + (mode == 2 ? 128 : 0));
    p0_item(W, N, 64 * kb, n0, gain, WT, K, drow0, scr, lane, full);
}
struct P0D { const float* W; const float* gain; unsigned char* dst; int ldw, k0, n0, ldk, drow0, kind; };
__device__ __forceinline__ P0D p0_mk(const float* W, int K, int N, const float* gain, void* WT, int mode, int item, int kind) {
    const int nblk = N / 32, kb = item / nblk, nb = item % nblk, n0 = 32 * nb;
    const int drow0 = mode == 0 ? n0 : (256 * (n0 >> 7) + (n0 & 127) + (mode == 2 ? 128 : 0));
    return P0D{W, gain, (unsigned char*)WT, N, 64 * kb, n0, K, drow0, kind};
}
__device__ __forceinline__ void p0_load(const P0D& d, f32x4 (&v)[8], float (&gk)[8], int lane) {
#pragma unroll
    for (int i = 0; i < 8; ++i) { const int kk = 8 * i + (lane >> 3); v[i] = __builtin_nontemporal_load((const GAS f32x4*)(d.W + (size_t)(d.k0 + kk) * d.ldw + d.n0 + 4 * (lane & 7))); gk[i] = (d.gain ? d.gain[d.k0 + kk] : 1.f) * (d.kind == 2 ? 64.f : 1.f); }
}
__device__ __forceinline__ void p0_finish(const P0D& d, const f32x4 (&v)[8], const float (&gk)[8], LAS float* scr, int lane) {
    const float lim = d.kind == 2 ? 448.f : 3.0e38f;
#pragma unroll
    for (int i = 0; i < 8; ++i) { const int kk = 8 * i + (lane >> 3); LAS float* p = scr + kk * 33 + 4 * (lane & 7);
        p[0] = __builtin_amdgcn_fmed3f(v[i].x * gk[i], -lim, lim); p[1] = __builtin_amdgcn_fmed3f(v[i].y * gk[i], -lim, lim); p[2] = __builtin_amdgcn_fmed3f(v[i].z * gk[i], -lim, lim); p[3] = __builtin_amdgcn_fmed3f(v[i].w * gk[i], -lim, lim); }
    LDS_WAIT(); asm volatile("" ::: "memory");
    const int c = lane & 7;
#pragma unroll
    for (int j = 0; j < 4; ++j) { const int n = (lane >> 3) + 8 * j; const LAS float* s = scr + (8 * c) * 33 + n;
        if (d.kind == 2) { int q0 = __builtin_amdgcn_cvt_pk_fp8_f32(s[0 * 33], s[1 * 33], 0, false); q0 = __builtin_amdgcn_cvt_pk_fp8_f32(s[2 * 33], s[3 * 33], q0, true);
            int q1 = __builtin_amdgcn_cvt_pk_fp8_f32(s[4 * 33], s[5 * 33], 0, false); q1 = __builtin_amdgcn_cvt_pk_fp8_f32(s[6 * 33], s[7 * 33], q1, true);
            v2u o; o.x = (unsigned)q0; o.y = (unsigned)q1; *(GAS v2u*)(d.dst + (size_t)(d.drow0 + n) * d.ldk + d.k0 + 8 * c) = o; }
        else { v4u o; if (d.kind == 1) { o.x = pk2(s[0 * 33], s[1 * 33]); o.y = pk2(s[2 * 33], s[3 * 33]); o.z = pk2(s[4 * 33], s[5 * 33]); o.w = pk2(s[6 * 33], s[7 * 33]); }
            else { o.x = WPK2(s[0 * 33], s[1 * 33]); o.y = WPK2(s[2 * 33], s[3 * 33]); o.z = WPK2(s[4 * 33], s[5 * 33]); o.w = WPK2(s[6 * 33], s[7 * 33]); }
            *(GAS v4u*)((bf16*)d.dst + (size_t)(d.drow0 + n) * d.ldk + d.k0 + 8 * c) = o; } }
    LDS_WAIT(); asm volatile("" ::: "memory");
}
__device__ __forceinline__ void norm_row(Frame& F, const float* xrow, bf16* orow, float* ssq_row) {
    const GAS f32x4* xr = (const GAS f32x4*)xrow + F.lane;
    f32x4 v[8]; float s = 0.f;
#pragma unroll
    for (int j = 0; j < 8; ++j) { v[j] = __builtin_nontemporal_load(xr + 64 * j); s += (v[j].x * v[j].x + v[j].y * v[j].y) + (v[j].z * v[j].z + v[j].w * v[j].w); }
    s = wave_sum(s);
    if (F.lane < 32) ssq_row[F.lane] = F.lane == 0 ? s : 0.f;
    GAS v2u* o8 = (GAS v2u*)orow + F.lane;
#pragma unroll
    for (int j = 0; j < 8; ++j) { v2u w; w.x = pk2(v[j].x, v[j].y); w.y = pk2(v[j].z, v[j].w); o8[64 * j] = w; }
}
__device__ __forceinline__ void norm_phase(Frame& F, const float* h) {
    const int gw = F.vcu * NWAVES + F.wave, NGW = F.G * NWAVES;
    bf16* HB = (bf16*)(F.ws + WS_HB); float* SQ = (float*)(F.ws + WS_SSQA);
    constexpr int NR = MK_NORM_ROWS;
    for (int m = gw; m < MT; m += NR * NGW) {
        f32x4 v[NR][8];
#pragma unroll
        for (int r = 0; r < NR; ++r) { const int mr = m + r * NGW < MT ? m + r * NGW : m; const GAS f32x4* xr = (const GAS f32x4*)(h + (size_t)mr * DM) + F.lane;
#pragma unroll
            for (int j = 0; j < 8; ++j) v[r][j] = __builtin_nontemporal_load(xr + 64 * j); }
#pragma unroll
        for (int r = 0; r < NR; ++r) { const int mr = m + r * NGW; if (mr < MT) { float s = 0.f;
#pragma unroll
            for (int j = 0; j < 8; ++j) s += (v[r][j].x * v[r][j].x + v[r][j].y * v[r][j].y) + (v[r][j].z * v[r][j].z + v[r][j].w * v[r][j].w);
            s = wave_sum(s);
            if (F.lane < 32) SQ[(size_t)mr * 32 + F.lane] = F.lane == 0 ? s : 0.f;
            GAS v2u* o8 = (GAS v2u*)(HB + (size_t)mr * DM) + F.lane;
#pragma unroll
            for (int j = 0; j < 8; ++j) { v2u w; w.x = pk2(v[r][j].x, v[r][j].y); w.y = pk2(v[r][j].z, v[r][j].w); o8[64 * j] = w; } } }
    }
}
__device__ __forceinline__ void final_norm_phase(Frame& F) {
    int tid_ = threadIdx.x; asm volatile("" : "+v"(tid_)); const int lane = tid_ & 63;
    const int gw = F.vcu * NWAVES + F.wave, NGW = F.G * NWAVES;
    const float* g = F.in[18]; const float* SQB = (const float*)(F.ws + WS_SSQB); const bf16* HBp = (const bf16*)(F.ws + WS_HB);
    f32x4 gv[8];
#pragma unroll
    for (int j = 0; j < 4; ++j) { gv[2 * j] = *(const GAS f32x4*)(g + 512 * j + 8 * lane); gv[2 * j + 1] = *(const GAS f32x4*)(g + 512 * j + 8 * lane + 4); }
    for (int m = gw; m < MT; m += 2 * NGW) {
        const int m2 = m + NGW < MT ? m + NGW : m;
        v4u hw[4], hw2[4];
#pragma unroll
        for (int j = 0; j < 4; ++j) hw[j] = *(const GAS v4u*)(HBp + (size_t)m * DM + 512 * j + 8 * lane);
#pragma unroll
        for (int j = 0; j < 4; ++j) hw2[j] = *(const GAS v4u*)(HBp + (size_t)m2 * DM + 512 * j + 8 * lane);
        const float sq1 = lane < 32 ? SQB[(size_t)m * 32 + lane] : 0.f, sq2 = lane < 32 ? SQB[(size_t)m2 * 32 + lane] : 0.f;
        const float rs1 = __builtin_amdgcn_rsqf(wave_sum(sq1) * (1.f / DM) + EPS), rs2 = __builtin_amdgcn_rsqf(wave_sum(sq2) * (1.f / DM) + EPS);
        GAS f32x4* orow = (GAS f32x4*)(F.out + (size_t)m * DM); GAS f32x4* orow2 = (GAS f32x4*)(F.out + (size_t)m2 * DM);
#pragma unroll
        for (int j = 0; j < 4; ++j) { const v4u q = hw[j];
            f32x4 a = {bflo(q.x), bfhi(q.x), bflo(q.y), bfhi(q.y)}, b2 = {bflo(q.z), bfhi(q.z), bflo(q.w), bfhi(q.w)};
            orow[128 * j + 2 * lane] = a * rs1 * gv[2 * j]; orow[128 * j + 2 * lane + 1] = b2 * rs1 * gv[2 * j + 1]; }
        if (m2 != m) {
#pragma unroll
            for (int j = 0; j < 4; ++j) { const v4u q = hw2[j];
                f32x4 a = {bflo(q.x), bfhi(q.x), bflo(q.y), bfhi(q.y)}, b2 = {bflo(q.z), bfhi(q.z), bflo(q.w), bfhi(q.w)};
                orow2[128 * j + 2 * lane] = a * rs2 * gv[2 * j]; orow2[128 * j + 2 * lane + 1] = b2 * rs2 * gv[2 * j + 1]; } }
    }
}
template <int PART> __device__ __forceinline__ void p0_prologue(Frame& F) {
    int tid_ = threadIdx.x; asm volatile("" : "+v"(tid_)); const int ptid = tid_, plane = tid_ & 63;
    LAS float* scr = (LAS float*)(F.lds + RING_OFF + F.wave * 16384);
    const int gw = F.vcu * NWAVES + F.wave, NGW = F.G * NWAVES;
    unsigned char* ws = F.ws;
    constexpr int I_IN0 = (DM / 64) * (EVEN_IN / 32), I_SQ = (DM / 64) * (DM / 32), I_IN1 = (DM / 64) * (LDQKV / 32), I_GU = (DM / 64) * (FF / 32), I_D = (FF / 64) * (DM / 32), I_PE = (PLE / 64) * (DM / 32);
    constexpr int PERL = 2 * I_GU + I_D + I_SQ + I_PE, I_IN = PART ? I_IN1 : I_IN0, NITEMS = I_IN + I_SQ + PERL, l = PART;
    auto decode = [&](int r) -> P0D {
        if (r < I_IN) return PART == 0 ? p0_mk(F.in[3], DM, EVEN_IN, F.in[2], ws + WS_WIN0, 0, r, 0) : p0_mk(F.in[9], DM, LDQKV, F.in[8], ws + WS_WIN1, 0, r, 0);
        r -= I_IN;
        if (r < I_SQ) return p0_mk(F.in[PART ? 10 : 7], DM, DM, nullptr, ws + (PART ? WS_WOUT1 : WS_WOUT0), 0, r, 0);
        r -= I_SQ;
        if (r < I_GU) return p0_mk(F.in[12] + (size_t)l * DM * FF, DM, FF, F.in[11] + l * DM, ws + WS_WGU + (size_t)l * 44 * MiB, 1, r, 0);
        r -= I_GU;
        if (r < I_GU) return p0_mk(F.in[13] + (size_t)l * DM * FF, DM, FF, F.in[11] + l * DM, ws + WS_WGU + (size_t)l * 44 * MiB, 2, r, 0);
        r -= I_GU;
        if (r < I_D) return p0_mk(F.in[14] + (size_t)l * FF * DM, FF, DM, nullptr, ws + WS_WD + (size_t)l * 22 * MiB, 0, r, 0);
        r -= I_D;
        if (r < I_SQ) return p0_mk(F.in[16] + (size_t)l * DM * DM, DM, DM, F.in[15] + l * DM, ws + WS_WPG + (size_t)l * 8 * MiB, 0, r, 2);
        r -= I_SQ;
        return p0_mk(F.in[17] + (size_t)l * PLE * DM, PLE, DM, nullptr, ws + WS_WPE + (size_t)l * 1 * MiB, 0, r, 1);
    };
    for (int it = gw; it < NITEMS; it += 2 * NGW) {
        const int itb = it + NGW; const bool two = itb < NITEMS;
        const P0D da = decode(it), db = decode(two ? itb : it);
        f32x4 va[8], vb[8]; float ga[8], gb[8];
        p0_load(da, va, ga, plane); p0_load(db, vb, gb, plane);
        p0_finish(da, va, ga, scr, plane); if (two) p0_finish(db, vb, gb, scr, plane);
    }
    { const GAS f32x4* ps = (const GAS f32x4*)(F.in[1] + (size_t)PART * MT * PLE); GAS v4u* pd = (GAS v4u*)(ws + WS_PB + (size_t)PART * MT * PLE * 2); const size_t n8 = (size_t)MT * PLE / 8;
      const size_t st = (size_t)F.G * 512;
      for (size_t i = (size_t)F.vcu * 512 + ptid; i < n8; i += 2 * st) { const size_t i2 = i + st < n8 ? i + st : i;
          const f32x4 a = __builtin_nontemporal_load(ps + 2 * i), b = __builtin_nontemporal_load(ps + 2 * i + 1), a2 = __builtin_nontemporal_load(ps + 2 * i2), b2 = __builtin_nontemporal_load(ps + 2 * i2 + 1);
          v4u o; o.x = pk2(a.x, a.y); o.y = pk2(a.z, a.w); o.z = pk2(b.x, b.y); o.w = pk2(b.z, b.w); pd[i] = o;
          v4u o2; o2.x = pk2(a2.x, a2.y); o2.y = pk2(a2.z, a2.w); o2.z = pk2(b2.x, b2.y); o2.w = pk2(b2.z, b2.w); pd[i2] = o2; } }
    if (PART == 0) {
        { GAS v4u* z = (GAS v4u*)(ws + WS_WIN0 + (size_t)EVEN_IN * DM * 2); const int n16 = 32 * DM * 2 / 16;
          for (int i = F.vcu * 512 + ptid; i < n16; i += F.G * 512) z[i] = (v4u){0u, 0u, 0u, 0u}; }
        norm_phase(F, F.in[0]);
    }
}
namespace att {
typedef unsigned u32x4v __attribute__((ext_vector_type(4)));
constexpr int TILE_B = 64 * 128 * 2;
constexpr int NSLOT = 4, K_OFF = 0, V_OFF = NSLOT * TILE_B, WS_OFF = 2 * NSLOT * TILE_B;
#define ATT_BAR() do { asm volatile("s_waitcnt lgkmcnt(0)" ::: "memory"); __builtin_amdgcn_s_barrier(); asm volatile("" ::: "memory"); } while (0)
constexpr int FLAG_OFF = WS_OFF + 8 * 64 * 4;
#define ATT_KSWZ(row, colB) ((row) * 256 + ((colB) ^ (((row) & 7) << 4)))
#define ATT_SBAR() __builtin_amdgcn_sched_barrier(0)
__device__ __forceinline__ int crow(int r, int hi) { return (r & 3) + 8 * (r >> 2) + 4 * hi; }
__device__ __forceinline__ unsigned cvtpk(float lo, float hi) { unsigned r; asm volatile("v_cvt_pk_bf16_f32 %0, %1, %2" : "=v"(r) : "v"(lo), "v"(hi)); return r; }
__device__ __forceinline__ int v_st(int k, int c) { const int kk = (k & ~0xC) | ((k & 4) << 1) | ((k & 8) >> 1); return ((kk >> 3) * 4 + (c >> 5)) * 512 + ((kk & 7) * 32 + (c & 31)) * 2; }
__device__ __forceinline__ int v_rd_base(int lane) { return ((lane & 3) << 3) | (((lane >> 2) & 3) << 6) | (((lane >> 4) & 1) << 5) | (((lane >> 5) & 1) << 8); }
constexpr int v_rd_off(int d0, int ks, int half) { return d0 * 512 + ks * 4096 + half * 2048; }
template <int OFF> __device__ __forceinline__ s16x4 tr_read(int vb) { s16x4 r; asm volatile("ds_read_b64_tr_b16 %0, %1 offset:%2" : "=&v"(r) : "v"(vb), "i"(OFF) : "memory"); return r; }
template <int D0> __device__ __forceinline__ void pv_one(f32x16& od, int vb, bf16x8 pa0, bf16x8 pa1, bf16x8 pa2, bf16x8 pa3) {
    const s16x4 l0 = tr_read<v_rd_off(D0, 0, 0)>(vb), h0 = tr_read<v_rd_off(D0, 0, 1)>(vb), l1 = tr_read<v_rd_off(D0, 1, 0)>(vb), h1 = tr_read<v_rd_off(D0, 1, 1)>(vb);
    const s16x4 l2 = tr_read<v_rd_off(D0, 2, 0)>(vb), h2 = tr_read<v_rd_off(D0, 2, 1)>(vb), l3 = tr_read<v_rd_off(D0, 3, 0)>(vb), h3 = tr_read<v_rd_off(D0, 3, 1)>(vb);
    asm volatile("s_waitcnt lgkmcnt(0)" ::: "memory"); ATT_SBAR();
#define ATT_PK(L, H) (bf16x8){L[0], L[1], L[2], L[3], H[0], H[1], H[2], H[3]}
    od = __builtin_amdgcn_mfma_f32_32x32x16_bf16(pa0, ATT_PK(l0, h0), od, 0, 0, 0);
    od = __builtin_amdgcn_mfma_f32_32x32x16_bf16(pa1, ATT_PK(l1, h1), od, 0, 0, 0);
    od = __builtin_amdgcn_mfma_f32_32x32x16_bf16(pa2, ATT_PK(l2, h2), od, 0, 0, 0);
    od = __builtin_amdgcn_mfma_f32_32x32x16_bf16(pa3, ATT_PK(l3, h3), od, 0, 0, 0);
#undef ATT_PK
}
__device__ __forceinline__ void pv_d0(f32x16* o, int vb, bf16x8 pa0, bf16x8 pa1, bf16x8 pa2, bf16x8 pa3) {
    pv_one<0>(o[0], vb, pa0, pa1, pa2, pa3); pv_one<1>(o[1], vb, pa0, pa1, pa2, pa3); pv_one<2>(o[2], vb, pa0, pa1, pa2, pa3); pv_one<3>(o[3], vb, pa0, pa1, pa2, pa3);
}
__device__ __forceinline__ void qkt(f32x16& p0, f32x16& p1, LAS const unsigned char* Ks, const bf16x8* qr, int r32, int hi) {
    p0 = f32x16{}; p1 = f32x16{};
#pragma unroll
    for (int d0 = 0; d0 < 8; ++d0) { const int cb = (d0 * 16 + hi * 8) * 2;
        const bf16x8 b0 = *(LAS const bf16x8*)(Ks + ATT_KSWZ(r32, cb));
        const bf16x8 b1 = *(LAS const bf16x8*)(Ks + ATT_KSWZ(32 + r32, cb));
        p0 = __builtin_amdgcn_mfma_f32_32x32x16_bf16(b0, qr[d0], p0, 0, 0, 0);
        p1 = __builtin_amdgcn_mfma_f32_32x32x16_bf16(b1, qr[d0], p1, 0, 0, 0); }
}
__device__ __forceinline__ void pack_p(const f32x16& p0, const f32x16& p1, bf16x8& pa0, bf16x8& pa1, bf16x8& pa2, bf16x8& pa3) {
#define ATT_PK4(P, BASE, OUT) do { unsigned a0 = cvtpk(P[BASE + 0], P[BASE + 1]), a1 = cvtpk(P[BASE + 2], P[BASE + 3]);   \
    unsigned b0 = cvtpk(P[BASE + 4], P[BASE + 5]), b1 = cvtpk(P[BASE + 6], P[BASE + 7]);                              \
    auto r0 = __builtin_amdgcn_permlane32_swap(a0, b0, false, false); auto r1 = __builtin_amdgcn_permlane32_swap(a1, b1, false, false); \
    u32x4v w = {r0[0], r1[0], r0[1], r1[1]}; OUT = __builtin_bit_cast(bf16x8, w); } while (0)
    ATT_PK4(p0, 0, pa0); ATT_PK4(p0, 8, pa1); ATT_PK4(p1, 0, pa2); ATT_PK4(p1, 8, pa3);
#undef ATT_PK4
}
__device__ __forceinline__ float lo_hi_sum(float v) { auto rr = __builtin_amdgcn_permlane32_swap(f2u(v), f2u(v), false, false);
    return u2f(rr[0]) + u2f(rr[1]); }
__device__ __forceinline__ float lo_hi_max(float v) { auto rr = __builtin_amdgcn_permlane32_swap(f2u(v), f2u(v), false, false);
    return fmaxf(u2f(rr[0]), u2f(rr[1])); }


__device__ __forceinline__ void dma_tile(LAS unsigned char* lds, int slot, const bf16* Kg, const bf16* Vg, int ld, int wid, int lane) {
#pragma unroll
    for (int e = 0; e < 2; ++e) { const int kk = 2 * wid + e;
        const int row = 4 * kk + (lane >> 4), ch = (lane & 15) ^ (row & 7);
        __builtin_amdgcn_global_load_lds((const unsigned*)(Kg + (size_t)row * ld + ch * 8), (LAS unsigned*)(lds + K_OFF + slot * TILE_B + kk * 1024), 16, 0, 0);
        const int st = 2 * kk + (lane >> 5), kx = 8 * (st >> 2) + ((lane & 31) >> 2), key = (kx & ~0xC) | ((kx & 4) << 1) | ((kx & 8) >> 1), col = 32 * (st & 3) + 8 * (lane & 3);
        __builtin_amdgcn_global_load_lds((const unsigned*)(Vg + (size_t)key * ld + col), (LAS unsigned*)(lds + V_OFF + slot * TILE_B + kk * 1024), 16, 0, 0); }
}

__device__ __forceinline__ void dsa_attn_unit(LAS unsigned char* lds, const bf16* __restrict__ U, const unsigned long long* __restrict__ MASK, bf16* __restrict__ OB, int b, int qb) {
    constexpr float SCALE = 0.088388347648318440f, C = SCALE * 1.4426950408889634f, THR = 8.f;
    int tid_ = threadIdx.x; asm volatile("" : "+v"(tid_));
    const int tid = tid_, wid = __builtin_amdgcn_readfirstlane(tid >> 6), lane = tid & 63, r32 = lane & 31, hi = lane >> 5;
    LAS float* wsc = (LAS float*)(lds + WS_OFF) + wid * 64; LAS float* li_l = wsc; LAS float* al_l = wsc + 32;
    const int NT = (qb >> 1) + 1;
    const int tq = b * SEQ + qb * 32 + wid * 4 + (r32 >> 3), head = r32 & 7;
    float m_reg = -1e30f, l_reg = 0.f; f32x16 o[4] = {}; bf16x8 qr[8];
    { const bf16* Qw = U + (size_t)tq * LDU + U_QA + head * 128 + hi * 8;
#pragma unroll
      for (int d0 = 0; d0 < 8; ++d0) qr[d0] = *(const bf16x8*)(Qw + d0 * 16); }
    const unsigned long long* mrow = MASK + (size_t)tq * 32;
    const bf16* Cb = U + (size_t)(b * SEQ) * LDU + U_CA;
    const int vb0 = (int)(uintptr_t)(lds + V_OFF) + v_rd_base(lane);
    unsigned long long mw = mrow[0], mw1 = mrow[NT > 1 ? 1 : 0];
    if (wid >= 4) __builtin_amdgcn_s_setprio(1);
    __syncthreads();
    dma_tile(lds, 0, Cb, Cb, LDU, wid, lane);
    dma_tile(lds, 1, Cb + (size_t)(NT > 1 ? 64 : 0) * LDU, Cb + (size_t)(NT > 1 ? 64 : 0) * LDU, LDU, wid, lane);
    const bool late = wid >= 4; int prev_bo = 0; bf16x8 pa0 = {}, pa1 = {}, pa2 = {}, pa3 = {};
    for (int j = 0; j < NT; ++j) {
        const int bo = (j % NSLOT) * TILE_B;
        asm volatile("s_waitcnt vmcnt(4)" ::: "memory");
        ATT_BAR();
        const unsigned long long mw2 = mrow[j + 2 < NT ? j + 2 : 0];
        { const int jn = j + 2 < NT ? j + 2 : 0;
          dma_tile(lds, (j + 2) % NSLOT, Cb + (size_t)jn * 64 * LDU, Cb + (size_t)jn * 64 * LDU, LDU, wid, lane); }
        if (late && j > 0) pv_d0(o, vb0 + prev_bo, pa0, pa1, pa2, pa3);
        f32x16 p0, p1;
        qkt(p0, p1, lds + K_OFF + bo, qr, r32, hi);
        { const unsigned wlo = (unsigned)mw >> (4 * hi), whi = (unsigned)(mw >> 32) >> (4 * hi);
#pragma unroll
          for (int r = 0; r < 16; ++r) { const int bit = (r & 3) + 8 * (r >> 2);
              const unsigned m0 = (unsigned)(((int)(wlo << (31 - bit))) >> 31), m1 = (unsigned)(((int)(whi << (31 - bit))) >> 31);
              p0[r] = u2f((f2u(p0[r]) & m0) | (0xff800000u & ~m0));
              p1[r] = u2f((f2u(p1[r]) & m1) | (0xff800000u & ~m1)); } }
        float pmax = p0[0];
#pragma unroll
        for (int r = 1; r < 16; ++r) pmax = fmaxf(pmax, p0[r]);
#pragma unroll
        for (int r = 0; r < 16; ++r) pmax = fmaxf(pmax, p1[r]);
        pmax = lo_hi_max(pmax);
        float mn, alpha;
        if (__all(pmax - m_reg <= THR / SCALE)) { mn = m_reg; alpha = 1.f; }
        else { mn = fmaxf(m_reg, pmax); alpha = __builtin_amdgcn_exp2f((m_reg - mn) * C); m_reg = mn; }
        const float mnC = -mn * C;
#pragma unroll
        for (int r = 0; r < 16; ++r) { p0[r] = __builtin_amdgcn_exp2f(fmaf(p0[r], C, mnC)); p1[r] = __builtin_amdgcn_exp2f(fmaf(p1[r], C, mnC)); }
        float ps = 0.f;
#pragma unroll
        for (int r = 0; r < 16; ++r) ps += p0[r] + p1[r];
        ps = lo_hi_sum(ps);
        l_reg = l_reg * alpha + ps;
        pack_p(p0, p1, pa0, pa1, pa2, pa3);
        if (__any(alpha < 1.f)) { if (hi == 0) al_l[r32] = alpha; asm volatile("s_waitcnt lgkmcnt(0)" ::: "memory");
#pragma unroll
            for (int d = 0; d < 4; ++d)
#pragma unroll
                for (int r = 0; r < 16; ++r) o[d][r] *= al_l[crow(r, hi)]; }
        if (late) prev_bo = bo; else pv_d0(o, vb0 + bo, pa0, pa1, pa2, pa3);
        mw = mw1; mw1 = mw2;
    }
    if (late) pv_d0(o, vb0 + prev_bo, pa0, pa1, pa2, pa3);
    asm volatile("s_waitcnt vmcnt(0)" ::: "memory"); ATT_BAR();
    __builtin_amdgcn_s_setprio(0);
    if (hi == 0) li_l[r32] = l_reg; asm volatile("s_waitcnt lgkmcnt(0)" ::: "memory");
    LAS unsigned char* ost = lds + K_OFF + wid * 8192;
#pragma unroll
    for (int r = 0; r < 16; ++r) { const int orow = crow(r, hi); const float rl = __builtin_amdgcn_rcpf(li_l[orow]);
#pragma unroll
        for (int d0 = 0; d0 < 4; ++d0) *(LAS unsigned short*)(ost + orow * 256 + (32 * d0 + r32) * 2) = (unsigned short)f2bf(o[d0][r] * rl); }
    asm volatile("s_waitcnt lgkmcnt(0)" ::: "memory");
    bf16* Ow = OB + (size_t)(b * SEQ + qb * 32 + wid * 4) * DM;
#pragma unroll
    for (int k = 0; k < 8; ++k) { const int orow = 4 * k + (lane >> 4); const v4u w = *(LAS const v4u*)(ost + orow * 256 + (lane & 15) * 16);
        *(v4u*)(Ow + (size_t)(orow >> 3) * DM + (orow & 7) * 128 + (lane & 15) * 8) = w; }
    asm volatile("s_waitcnt lgkmcnt(0)" ::: "memory");
}
__device__ __forceinline__ void dsa_attn_phase(Frame& F) {
    const bf16* U = (const bf16*)(F.ws + WS_BIG); const unsigned long long* MASK = (const unsigned long long*)(F.ws + WS_MASK); bf16* OB = (bf16*)(F.ws + WS_OB);
    for (int wg = F.vcu; wg < 256; wg += F.G) { const int b = wg >> 4, i = wg & 15;
#pragma unroll 1
        for (int k = 0; k < 4; ++k) { const int qb = k == 0 ? 63 - i : (k == 1 ? 32 + i : (k == 2 ? 31 - i : i)); dsa_attn_unit(F.lds, U, MASK, OB, b, qb); } }
}

__device__ __forceinline__ void sb_unit(LAS unsigned char* lds, const bf16* __restrict__ QKV, bf16* __restrict__ OB, int b, int h, int i) {
    constexpr float C = 0.088388347648318440f * 1.4426950408889634f, DONE_THR = 160.f;
    int tid_ = threadIdx.x; asm volatile("" : "+v"(tid_));
    const int tid = tid_, wid = __builtin_amdgcn_readfirstlane(tid >> 6), lane = tid & 63, r32 = lane & 31, hi = lane >> 5;
    LAS volatile unsigned* flags = (LAS volatile unsigned*)(lds + FLAG_OFF);
#if MK_SB_PROF
    LAS volatile unsigned* prof = (LAS volatile unsigned*)(lds + MISC_OFF) + 16; unsigned long long pt0 = __builtin_amdgcn_s_memrealtime();
#define SB_PROF(k) do { if (tid == 0) { const unsigned long long pt1 = __builtin_amdgcn_s_memrealtime(); prof[k] += (unsigned)(pt1 - pt0); pt0 = pt1; } } while (0)
#else
#define SB_PROF(k) do { } while (0)
#endif
    const int t = 256 * i + 32 * wid + r32;
    f32x16 o[4] = {}; bf16x8 qr[8];
    { const bf16* Qw = QKV + (size_t)(b * SEQ + t) * LDQKV + h * 128 + hi * 8;
#pragma unroll
      for (int d0 = 0; d0 < 8; ++d0) qr[d0] = *(const bf16x8*)(Qw + d0 * 16); }
    const bf16* Kb = QKV + (size_t)(b * SEQ) * LDQKV + 2048 + h * 128; const bf16* Vb = Kb + 2048;
    const int vb0 = (int)(uintptr_t)(lds + V_OFF) + v_rd_base(lane);
    const float f0 = hi ? 0.f : 1.f;
    float Rneg = 0.f;
    int jt = 4 * i + 3;
    if (wid >= 4) __builtin_amdgcn_s_setprio(1);
    __syncthreads();
    dma_tile(lds, 0, Kb + (size_t)(jt * 64) * LDQKV, Vb + (size_t)(jt * 64) * LDQKV, LDQKV, wid, lane);
    dma_tile(lds, 1, Kb + (size_t)((jt - 1) * 64) * LDQKV, Vb + (size_t)((jt - 1) * 64) * LDQKV, LDQKV, wid, lane);
    SB_PROF(0);
    const bool late = wid >= 4; bool have = false; int prev_bo = 0; bf16x8 pa0 = {}, pa1 = {}, pa2 = {}, pa3 = {};
    for (int it = 0; jt >= 0; ++it, --jt) {
        const int bo = (it % NSLOT) * TILE_B;
        asm volatile("s_waitcnt vmcnt(4)" ::: "memory");
        ATT_BAR();
        SB_PROF(3);
        { unsigned a = 1u;
#pragma unroll
          for (int w = 0; w < 8; ++w) a &= flags[((it + 1) & 1) * 8 + w];
          if (it > 0 && a) break; }
        { const int jn = jt >= 2 ? jt - 2 : 0;
          dma_tile(lds, (it + 2) % NSLOT, Kb + (size_t)(jn * 64) * LDQKV, Vb + (size_t)(jn * 64) * LDQKV, LDQKV, wid, lane); }
        const bool wdone = __all(Rneg > DONE_THR);
        if (late && have) { pv_d0(o, vb0 + prev_bo, pa0, pa1, pa2, pa3); have = false; }
        const bool above = 64 * jt >= 256 * i + 32 * wid + 31;
        if (!wdone && !above) {
            const int kbase = jt * 64 + 4 * hi - t;
            const bool diag = jt >= 4 * i;
            f32x16 pu = {}, pl = {};
#pragma unroll
            for (int d0 = 0; d0 < 8; ++d0) { const int cb = (d0 * 16 + hi * 8) * 2;
                const bf16x8 kfu = *(LAS const bf16x8*)(lds + K_OFF + bo + ATT_KSWZ(32 + r32, cb)), kfl = *(LAS const bf16x8*)(lds + K_OFF + bo + ATT_KSWZ(r32, cb));
                pu = __builtin_amdgcn_mfma_f32_32x32x16_bf16(kfu, qr[d0], pu, 0, 0, 0); pl = __builtin_amdgcn_mfma_f32_32x32x16_bf16(kfl, qr[d0], pl, 0, 0, 0); }
#define SB_HALF(p, KD0, PA, PB) do { \
            _Pragma("unroll") for (int r = 0; r < 16; ++r) p[r] = fminf(p[r], 64.f);     \
            if (diag) { _Pragma("unroll") for (int r = 0; r < 16; ++r) { if (kbase + (KD0) + (r & 3) + 8 * (r >> 2) >= 0) p[r] = -1e30f; } } \
            f32x16 u1; \
            _Pragma("unroll") for (int r = 0; r < 16; ++r) { p[r] = __builtin_amdgcn_exp2f(p[r]); u1[r] = 1.0f + p[r]; }     \
            float Lo[4], Up[4]; \
            _Pragma("unroll") for (int g = 0; g < 4; ++g) { const float T = (u1[4 * g] * u1[4 * g + 1]) * (u1[4 * g + 2] * u1[4 * g + 3]); \
                auto rr = __builtin_amdgcn_permlane32_swap(f2u(T), f2u(T), false, false); \
                Lo[g] = u2f(rr[0]); Up[g] = u2f(rr[1]); } \
            float run = __builtin_amdgcn_exp2f(Rneg);     \
            _Pragma("unroll") for (int g = 3; g >= 0; --g) { const float off = run * (hi ? 1.0f : Up[g]); run *= Up[g] * Lo[g]; \
                const float q3 = off * u1[4 * g + 3], q2 = q3 * u1[4 * g + 2], q1 = q2 * u1[4 * g + 1], q0 = q1 * u1[4 * g]; \
                p[4 * g + 3] *= __builtin_amdgcn_rcpf(q3); p[4 * g + 2] *= __builtin_amdgcn_rcpf(q2); p[4 * g + 1] *= __builtin_amdgcn_rcpf(q1); p[4 * g] *= __builtin_amdgcn_rcpf(q0); } \
            Rneg = __builtin_amdgcn_logf(run); \
            { unsigned a0 = cvtpk(p[0], p[1]), a1 = cvtpk(p[2], p[3]), b0 = cvtpk(p[4], p[5]), b1 = cvtpk(p[6], p[7]); \
              auto r0 = __builtin_amdgcn_permlane32_swap(a0, b0, false, false); auto r1 = __builtin_amdgcn_permlane32_swap(a1, b1, false, false); \
              u32x4v w = {r0[0], r1[0], r0[1], r1[1]}; PA = __builtin_bit_cast(bf16x8, w); } \
            { unsigned a0 = cvtpk(p[8], p[9]), a1 = cvtpk(p[10], p[11]), b0 = cvtpk(p[12], p[13]), b1 = cvtpk(p[14], p[15]); \
              auto r0 = __builtin_amdgcn_permlane32_swap(a0, b0, false, false); auto r1 = __builtin_amdgcn_permlane32_swap(a1, b1, false, false); \
              u32x4v w = {r0[0], r1[0], r0[1], r1[1]}; PB = __builtin_bit_cast(bf16x8, w); } } while (0)
            SB_HALF(pu, 32, pa2, pa3);
            SB_HALF(pl, 0, pa0, pa1);
#undef SB_HALF
            if (late) { have = true; prev_bo = bo; } else pv_d0(o, vb0 + bo, pa0, pa1, pa2, pa3);
        }
        if (lane == 0) flags[(it & 1) * 8 + wid] = wdone ? 1u : 0u;
        SB_PROF(1);
    }
    if (late && have) pv_d0(o, vb0 + prev_bo, pa0, pa1, pa2, pa3);
    asm volatile("s_waitcnt vmcnt(0)" ::: "memory"); ATT_BAR();
    __builtin_amdgcn_s_setprio(0);
    LAS unsigned char* ost = lds + K_OFF + wid * 8192;
#pragma unroll
    for (int r = 0; r < 16; ++r) { const int orow = crow(r, hi);
#pragma unroll
        for (int d0 = 0; d0 < 4; ++d0) *(LAS unsigned short*)(ost + orow * 256 + (32 * d0 + r32) * 2) = (unsigned short)f2bf(o[d0][r]); }
    asm volatile("s_waitcnt lgkmcnt(0)" ::: "memory");
    bf16* Ow = OB + (size_t)(b * SEQ + 256 * i + 32 * wid) * DM + h * 128;
#pragma unroll
    for (int k = 0; k < 8; ++k) { const int orow = 4 * k + (lane >> 4); const v4u w = *(LAS const v4u*)(ost + orow * 256 + (lane & 15) * 16);
        *(v4u*)(Ow + (size_t)orow * DM + (lane & 15) * 8) = w; }
    asm volatile("s_waitcnt lgkmcnt(0)" ::: "memory");
    SB_PROF(2);
#undef SB_PROF
}
__device__ __forceinline__ void sb_phase(Frame& F) {
    const bf16* QKV = (const bf16*)(F.ws + WS_BIG); bf16* OB = (bf16*)(F.ws + WS_OB);
    for (int wg = F.vcu; wg < 256; wg += F.G) { const int b = wg >> 4, h = wg & 15;
#pragma unroll 1
        for (int i = 7; i >= 0; --i) sb_unit(F.lds, QKV, OB, b, h, i); }
}
}
namespace idx {
constexpr int STAGE_KEYS = 256, STAGE_B = STAGE_KEYS * 128, NST = 3;
#define IDX_BAR() do { asm volatile("s_waitcnt lgkmcnt(0)" ::: "memory"); __builtin_amdgcn_s_barrier(); asm volatile("" ::: "memory"); } while (0)
__device__ __forceinline__ unsigned mono(float f) { const unsigned u = __builtin_bit_cast(unsigned, f); return u ^ ((unsigned)((int)u >> 31) | 0x80000000u); }
__device__ __forceinline__ void topk_unit(LAS unsigned char* lds, const bf16* __restrict__ U, unsigned* __restrict__ MASKW, int b, int g) {
    int tid_ = threadIdx.x; asm volatile("" : "+v"(tid_));
    const int tid = tid_, wid = __builtin_amdgcn_readfirstlane(tid >> 6), lane = tid & 63, r32 = lane & 31, hi = lane >> 5;
    const int t0 = 16 * g, nk = ((t0 >> 6) + 1) << 6, ntile = nk >> 5, nstage = (nk + STAGE_KEYS - 1) / STAGE_KEYS;
#if MK_IDX_PROF
    LAS volatile unsigned* prof = (LAS volatile unsigned*)(lds + MISC_OFF) + 16; unsigned long long pt0 = __builtin_amdgcn_s_memrealtime();
#define IDX_PROF(k) do { if (tid == 0) { const unsigned long long pt1 = __builtin_amdgcn_s_memrealtime(); prof[k] += (unsigned)(pt1 - pt0); pt0 = pt1; } } while (0)
#else
#define IDX_PROF(k) do { } while (0)
#endif
    const int tok0 = b * SEQ + t0 + 2 * wid;
    bf16x8 qa[4]; float wq[16];
    { const bf16* qp = U + (size_t)(tok0 + (r32 >> 4)) * LDU + U_QI + (r32 & 15) * 64 + hi * 8;
#pragma unroll
      for (int ks = 0; ks < 4; ++ks) qa[ks] = *(const bf16x8*)(qp + ks * 16);
#pragma unroll
      for (int q = 0; q < 2; ++q)
#pragma unroll
          for (int blk = 0; blk < 2; ++blk) { const v2u w = *(const v2u*)(U + (size_t)(tok0 + q) * LDU + U_WI + 8 * blk + 4 * hi);
              wq[8 * q + 4 * blk + 0] = bflo(w.x); wq[8 * q + 4 * blk + 1] = bfhi(w.x); wq[8 * q + 4 * blk + 2] = bflo(w.y); wq[8 * q + 4 * blk + 3] = bfhi(w.y); } }
    const bf16* kg = U + (size_t)(b * SEQ + (lane >> 3)) * LDU + U_KI + (((lane & 7) ^ (lane >> 3)) * 8);
#define IDX_DMA(SLOT, STG) do { _Pragma("unroll") for (int e = 0; e < 4; ++e) { const int kk = 4 * wid + e; \
        __builtin_amdgcn_global_load_lds((const unsigned*)(kg + (size_t)((STG) * STAGE_KEYS + 8 * kk) * LDU), (LAS unsigned*)(lds + (SLOT) * STAGE_B + kk * 1024), 16, 0, 0); } } while (0)
    __syncthreads();
    IDX_DMA(0, 0); IDX_DMA(1, (nstage > 1 ? 1 : 0));
    float sc[64];
#pragma unroll
    for (int i = 0; i < 64; ++i) sc[i] = -__builtin_inff();
    const int rdrow = r32 * 128, rdx = r32 & 7;
#pragma unroll
    for (int s = 0; s < 8; ++s) {
        if (s < nstage) {
            asm volatile("s_waitcnt vmcnt(4)" ::: "memory");
            IDX_BAR();
            IDX_DMA((s + 2) % NST, (s + 2 < nstage ? s + 2 : 0));
            LAS const unsigned char* kb = lds + (s % NST) * STAGE_B + rdrow;
#pragma unroll
            for (int tp = 0; tp < 4; ++tp) {
                const int i = s * 8 + 2 * tp;
                if (i < ntile) {
                    f32x16 acc0 = {}, acc1 = {};
#pragma unroll
                    for (int ks = 0; ks < 4; ++ks) { const bf16x8 kf0 = *(LAS const bf16x8*)(kb + (2 * tp) * 32 * 128 + (((2 * ks + hi) ^ rdx) * 16)), kf1 = *(LAS const bf16x8*)(kb + (2 * tp + 1) * 32 * 128 + (((2 * ks + hi) ^ rdx) * 16));
                        acc0 = __builtin_amdgcn_mfma_f32_32x32x16_bf16(qa[ks], kf0, acc0, 0, 0, 0); acc1 = __builtin_amdgcn_mfma_f32_32x32x16_bf16(qa[ks], kf1, acc1, 0, 0, 0); }
                    float p0 = 0.f, p1 = 0.f, p2 = 0.f, p3 = 0.f;
#pragma unroll
                    for (int r = 0; r < 8; ++r) { p0 = fmaf(wq[r], fmaxf(acc0[r], 0.f), p0); p1 = fmaf(wq[8 + r], fmaxf(acc0[8 + r], 0.f), p1); p2 = fmaf(wq[r], fmaxf(acc1[r], 0.f), p2); p3 = fmaf(wq[8 + r], fmaxf(acc1[8 + r], 0.f), p3); }
                    auto ra = __builtin_amdgcn_permlane32_swap(f2u(p0), f2u(p1), false, false); auto rb = __builtin_amdgcn_permlane32_swap(f2u(p2), f2u(p3), false, false);
                    sc[i] = (u2f(ra[0]) + u2f(ra[1])) * 0.03125f; sc[i + 1] = (u2f(rb[0]) + u2f(rb[1])) * 0.03125f;
                }
            }
        }
    }
    asm volatile("s_waitcnt vmcnt(0)" ::: "memory"); IDX_BAR();
#undef IDX_DMA
    IDX_PROF(0);
    float Tv = -__builtin_inff(); int rem0 = 0, rem1 = 0;
    if (nk > 256) {
        float mn = __builtin_inff(), mx = -__builtin_inff();
#pragma unroll
        for (int i = 0; i < 64; ++i) if (i < ntile) { mn = fminf(mn, sc[i]); mx = fmaxf(mx, sc[i]); }
#pragma unroll
        for (int o = 1; o < 32; o <<= 1) { mn = fminf(mn, __shfl_xor(mn, o)); mx = fmaxf(mx, __shfl_xor(mx, o)); }
        const unsigned mxu = f2u(mx);
        float lo = mn, hx = (mx == 0.f) ? 1.17549435e-38f : u2f((int)mxu >= 0 ? mxu + 1u : mxu - 1u);
        float flo = (float)nk - 255.5f, fhx = -255.5f;
        int side = 0;
        bool d0 = false, d1 = false;
#define IDX_BITS(BA, BB, EXPR) do { BA = 0u; BB = 0u; \
            _Pragma("unroll") for (int s = 0; s < 4; ++s) if (s < nstage) { _Pragma("unroll") for (int tt = 0; tt < 8; ++tt) { const float v_ = sc[s * 8 + tt]; BA = __builtin_amdgcn_alignbit(BA, f2u(EXPR), 31); } } \
            _Pragma("unroll") for (int s = 4; s < 8; ++s) if (s < nstage) { _Pragma("unroll") for (int tt = 0; tt < 8; ++tt) { const float v_ = sc[s * 8 + tt]; BB = __builtin_amdgcn_alignbit(BB, f2u(EXPR), 31); } } } while (0)
#define IDX_HALFSUM(N, C) do { int c_ = (C); \
            c_ += __builtin_amdgcn_update_dpp(0, c_, 0xB1, 0xF, 0xF, true); c_ += __builtin_amdgcn_update_dpp(0, c_, 0x4E, 0xF, 0xF, true);        \
            c_ += __builtin_amdgcn_update_dpp(0, c_, 0x124, 0xF, 0xF, true); c_ += __builtin_amdgcn_update_dpp(0, c_, 0x128, 0xF, 0xF, true);      \
            auto r_ = __builtin_amdgcn_permlane16_swap((unsigned)c_, (unsigned)c_, false, false); N = (int)r_[0] + (int)r_[1]; } while (0)
#pragma unroll 1
        for (int it = 0; it < 360; ++it) {
            const float fr = it < 24 ? flo * __builtin_amdgcn_rcpf(flo - fhx) : 0.5f;
            float mid = lo * (1.0f - fr) + hx * fr;
            if (!(mid > lo && mid < hx)) mid = lo * 0.5f + hx * 0.5f;
            const bool adj = !(mid > lo && mid < hx);
            const unsigned long long am = __builtin_amdgcn_ballot_w64(adj);
            if ((unsigned)am) d0 = true; if ((unsigned)(am >> 32)) d1 = true;
            if (d0 && d1) break;
            int nh; { unsigned ba, bb; IDX_BITS(ba, bb, v_ - mid); IDX_HALFSUM(nh, 8 * (nstage < 8 ? nstage : 8) - __builtin_popcount(ba) - __builtin_popcount(bb)); }
            const bool dh = hi ? d1 : d0;
            if (!dh) { const float f = (float)nh - 255.5f;
                if (nh >= 256) { lo = mid; flo = f; if (side > 0) fhx *= 0.5f; side = 1; }
                else { hx = mid; fhx = f; if (side < 0) flo *= 0.5f; side = -1; } }
            const unsigned long long hm = __builtin_amdgcn_ballot_w64(nh == 256);
            if ((unsigned)hm) d0 = true; if ((unsigned)(hm >> 32)) d1 = true;
        }
        { int ng; unsigned ba, bb; IDX_BITS(ba, bb, lo - v_); IDX_HALFSUM(ng, __builtin_popcount(ba) + __builtin_popcount(bb)); rem0 = 256 - __builtin_amdgcn_readfirstlane(ng); rem1 = 256 - __builtin_amdgcn_readlane(ng, 32); }
#undef IDX_BITS
#undef IDX_HALFSUM
        Tv = lo;
    }
    IDX_PROF(1);
    unsigned m0 = 0u, m1 = 0u;
#pragma unroll
    for (int i = 0; i < 64; ++i) {
        const unsigned long long gt = __builtin_amdgcn_ballot_w64(sc[i] > Tv);
        unsigned w0 = (unsigned)gt, w1 = (unsigned)(gt >> 32);
        if (rem0 | rem1) {
            const unsigned long long eq = __builtin_amdgcn_ballot_w64(sc[i] == Tv);
            unsigned e0 = rem0 > 0 ? (unsigned)eq : 0u, e1 = rem1 > 0 ? (unsigned)(eq >> 32) : 0u;
            while (__builtin_popcount(e0) > rem0) e0 &= ~(0x80000000u >> __builtin_clz(e0));
            while (__builtin_popcount(e1) > rem1) e1 &= ~(0x80000000u >> __builtin_clz(e1));
            rem0 -= __builtin_popcount(e0); rem1 -= __builtin_popcount(e1); w0 |= e0; w1 |= e1;
        }
        m0 = (lane == i) ? w0 : m0; m1 = (lane == i) ? w1 : m1;
    }
    __hip_atomic_store(MASKW + (size_t)tok0 * 64 + lane, m0, __ATOMIC_RELAXED, __HIP_MEMORY_SCOPE_AGENT); __hip_atomic_store(MASKW + (size_t)(tok0 + 1) * 64 + lane, m1, __ATOMIC_RELAXED, __HIP_MEMORY_SCOPE_AGENT);
    IDX_PROF(2);
#undef IDX_PROF
}
}
namespace gla {
constexpr int QE_OFF = 0, KE_OFF = 17408, KDT_OFF = 34816, ATT_OFF = 53248, O_OFF = 0, V_OFF = 66560, G_OFF = 99328, LR_OFF = 132096, TOT_OFF = 136192, DEC_OFF = 140288, WG_OFF = 140800, BG_OFF = 148992, GN_OFF = 149504;
constexpr int QP = 272, KTP = 144, VP = 512, OP = 1040;
#define GLA_BAR() do { asm volatile("s_waitcnt lgkmcnt(0)" ::: "memory"); __builtin_amdgcn_s_barrier(); asm volatile("" ::: "memory"); } while (0)
__device__ __forceinline__ s16x4 tr_read0(int addr) { s16x4 r; asm volatile("ds_read_b64_tr_b16 %0, %1" : "=&v"(r) : "v"(addr) : "memory"); return r; }
__device__ __forceinline__ void gla_unit(LAS unsigned char* lds, const bf16* __restrict__ U, const float* __restrict__ w_gk, const float* __restrict__ b_gk, const float* __restrict__ gnorm, bf16* __restrict__ OB, int b, int h) {
    constexpr float LOG2E = 1.4426950408889634f;
    int tid_ = threadIdx.x; asm volatile("" : "+v"(tid_));
    const int tid = tid_, wid = __builtin_amdgcn_readfirstlane(tid >> 6), lane = tid & 63, r32 = lane & 31, hi = lane >> 5;
    const int d0 = 2 * lane;
    LAS float* WG = (LAS float*)(lds + WG_OFF); LAS float* BG = (LAS float*)(lds + BG_OFF); LAS float* GN = (LAS float*)(lds + GN_OFF);
    __syncthreads();
#pragma unroll
    for (int k = 0; k < 4; ++k) { const int e = tid + 512 * k, r = e >> 7, d = e & 127; WG[r * 128 + d] = w_gk[r * 512 + h * 128 + d]; }
    if (tid < 128) BG[tid] = b_gk[h * 128 + tid];
    if (tid < 256) GN[tid] = gnorm[tid];
    f32x16 S[4] = {};
    LAS float* LR = (LAS float*)(lds + LR_OFF); LAS float* TOT = (LAS float*)(lds + TOT_OFF); LAS float* DEC = (LAS float*)(lds + DEC_OFF);
    const int ldsb = (int)(uintptr_t)lds;
    const int vtr = ldsb + V_OFF + (8 * (lane >> 5) + ((lane & 15) >> 2)) * VP + (32 * wid + 16 * ((lane >> 4) & 1) + 4 * (lane & 3)) * 2;
#define GLA_DMA(LOFF, COL0, TOK) do { _Pragma("unroll") for (int k4 = 0; k4 < 4; ++k4) { const int kk = wid * 4 + k4; \
        __builtin_amdgcn_global_load_lds((const unsigned*)(U + (size_t)((TOK) + 2 * kk + (lane >> 5)) * LDU + (COL0) + h * 256 + (lane & 31) * 8), (LAS unsigned*)(lds + (LOFF) + kk * 1024), 16, 0, 0); } } while (0)
    unsigned lrw, qw[8], kw[8];
    { const int tokp = b * SEQ; GLA_DMA(V_OFF, U_VB, tokp); GLA_DMA(G_OFF, U_GB, tokp);
      lrw = *(const unsigned*)(U + (size_t)(tokp + (tid >> 3)) * LDU + U_LR + (tid & 7) * 2);
#pragma unroll
      for (int j = 0; j < 8; ++j) { const bf16* up = U + (size_t)(tokp + 8 * wid + j) * LDU + h * 128 + d0; qw[j] = *(const unsigned*)(up + U_QB); kw[j] = *(const unsigned*)(up + U_KB); } }
#if MK_GLA_PROF
    LAS volatile unsigned* prof = (LAS volatile unsigned*)(lds + MISC_OFF) + 16; unsigned long long pt0 = __builtin_amdgcn_s_memrealtime();
#define GLA_PROF(k) do { if (tid == 0) { const unsigned long long pt1 = __builtin_amdgcn_s_memrealtime(); prof[k] += (unsigned)(pt1 - pt0); pt0 = pt1; } } while (0)
#else
#define GLA_PROF(k) do { } while (0)
#endif
#pragma unroll 1
    for (int n = 0; n < 32; ++n) {
        const int tok0 = b * SEQ + n * 64, tokn = tok0 + (n < 31 ? 64 : 0);
        { const int c = tid >> 3, r0 = (tid & 7) * 2; LR[c * 16 + r0] = bflo(lrw); LR[c * 16 + r0 + 1] = bfhi(lrw); }
        GLA_BAR();
        float G[2][8];
        f32x4 w0[4], w1[4];
#pragma unroll
        for (int r4 = 0; r4 < 4; ++r4)
#pragma unroll
            for (int e = 0; e < 4; ++e) { const f32x2 wv = *(LAS const f32x2*)(WG + (4 * r4 + e) * 128 + d0); w0[r4][e] = wv.x; w1[r4][e] = wv.y; }
        const f32x2 bg2 = *(LAS const f32x2*)(BG + d0);
#pragma unroll
        for (int j = 0; j < 8; ++j) { const int c = 8 * wid + j; float x0 = bg2.x, x1 = bg2.y;
#pragma unroll
            for (int r4 = 0; r4 < 4; ++r4) { const f32x4 l4 = *(LAS const f32x4*)(LR + c * 16 + 4 * r4);
#pragma unroll
                for (int e = 0; e < 4; ++e) { x0 = fmaf(l4[e], w0[r4][e], x0); x1 = fmaf(l4[e], w1[r4][e], x1); } }
            const float g0 = (fminf(x0, 0.f) * LOG2E - __builtin_amdgcn_logf(1.0f + __builtin_amdgcn_exp2f(-__builtin_fabsf(x0) * LOG2E))) * 0.0625f;
            const float g1 = (fminf(x1, 0.f) * LOG2E - __builtin_amdgcn_logf(1.0f + __builtin_amdgcn_exp2f(-__builtin_fabsf(x1) * LOG2E))) * 0.0625f;
            G[0][j] = g0 + (j ? G[0][j - 1] : 0.f); G[1][j] = g1 + (j ? G[1][j - 1] : 0.f); }
        TOT[wid * 128 + d0] = G[0][7]; TOT[wid * 128 + d0 + 1] = G[1][7];
        GLA_BAR();
        GLA_PROF(0);
        float off0 = 0.f, off1 = 0.f, gl0 = 0.f, gl1 = 0.f;
#pragma unroll
        for (int w = 0; w < 8; ++w) { const f32x2 t2 = *(LAS const f32x2*)(TOT + w * 128 + d0); if (w < wid) { off0 += t2.x; off1 += t2.y; } gl0 += t2.x; gl1 += t2.y; }
#pragma unroll
        for (int j = 0; j < 8; ++j) { const int c = 8 * wid + j; const float G0 = G[0][j] + off0, G1 = G[1][j] + off1;
            const float e0 = __builtin_amdgcn_exp2f(G0), e1 = __builtin_amdgcn_exp2f(G1), i0 = __builtin_amdgcn_exp2f(-G0), i1 = __builtin_amdgcn_exp2f(-G1);
            const float x0 = __builtin_amdgcn_exp2f(gl0 - G0), x1 = __builtin_amdgcn_exp2f(gl1 - G1);
            const float q0 = bflo(qw[j]), q1 = bfhi(qw[j]), k0 = bflo(kw[j]), k1 = bfhi(kw[j]);
            *(LAS unsigned*)(lds + QE_OFF + c * QP + d0 * 2) = pk2(q0 * e0 * 0.08838834764831845f, q1 * e1 * 0.08838834764831845f);
            *(LAS unsigned*)(lds + KE_OFF + c * QP + d0 * 2) = pk2(k0 * i0, k1 * i1);
            *(LAS unsigned short*)(lds + KDT_OFF + d0 * KTP + c * 2) = (unsigned short)f2bf(k0 * x0);
            *(LAS unsigned short*)(lds + KDT_OFF + (d0 + 1) * KTP + c * 2) = (unsigned short)f2bf(k1 * x1); }
        if (wid == 0) { DEC[d0] = __builtin_amdgcn_exp2f(gl0); DEC[d0 + 1] = __builtin_amdgcn_exp2f(gl1); }
        GLA_BAR();
        GLA_PROF(1);
        if (wid < 3) { const int rt = wid ? 1 : 0, ct = wid == 2 ? 1 : 0; f32x16 acc = {};
#pragma unroll
            for (int ks = 0; ks < 8; ++ks) { const bf16x8 a = *(LAS const bf16x8*)(lds + KE_OFF + (32 * ct + r32) * QP + (16 * ks + 8 * hi) * 2);
                const bf16x8 bq = *(LAS const bf16x8*)(lds + QE_OFF + (32 * rt + r32) * QP + (16 * ks + 8 * hi) * 2);
                acc = __builtin_amdgcn_mfma_f32_32x32x16_bf16(a, bq, acc, 0, 0, 0); }
            const int c = 32 * rt + r32;
#pragma unroll
            for (int q4 = 0; q4 < 4; ++q4) { const int s0 = 32 * ct + 8 * q4 + 4 * hi; float v[4];
#pragma unroll
                for (int e = 0; e < 4; ++e) v[e] = (s0 + e <= c) ? acc[4 * q4 + e] : 0.f;
                v2u w; w.x = pk2(v[0], v[1]); w.y = pk2(v[2], v[3]); *(LAS v2u*)(lds + ATT_OFF + c * KTP + s0 * 2) = w; } }
        asm volatile("s_waitcnt vmcnt(0)" ::: "memory");
        GLA_BAR();
        GLA_PROF(2);
        lrw = *(const unsigned*)(U + (size_t)(tokn + (tid >> 3)) * LDU + U_LR + (tid & 7) * 2);
#pragma unroll
        for (int j = 0; j < 8; ++j) { const bf16* up = U + (size_t)(tokn + 8 * wid + j) * LDU + h * 128 + d0; qw[j] = *(const unsigned*)(up + U_QB); kw[j] = *(const unsigned*)(up + U_KB); }
        bf16x8 vf[4];
        { s16x4 tl[4], th[4];
#pragma unroll
          for (int ks = 0; ks < 4; ++ks) { tl[ks] = tr_read0(vtr + (16 * ks) * VP); th[ks] = tr_read0(vtr + (16 * ks + 4) * VP); }
          asm volatile("s_waitcnt lgkmcnt(0)" ::: "memory"); __builtin_amdgcn_sched_barrier(0);
#pragma unroll
          for (int ks = 0; ks < 4; ++ks) vf[ks] = (bf16x8){tl[ks][0], tl[ks][1], tl[ks][2], tl[ks][3], th[ks][0], th[ks][1], th[ks][2], th[ks][3]}; }
        f32x16 o0 = {}, o1 = {};
#pragma unroll
        for (int ks = 0; ks < 4; ++ks) { const bf16x8 a1 = *(LAS const bf16x8*)(lds + ATT_OFF + (32 + r32) * KTP + (16 * ks + 8 * hi) * 2);
            o1 = __builtin_amdgcn_mfma_f32_32x32x16_bf16(a1, vf[ks], o1, 0, 0, 0);
            if (ks < 2) { const bf16x8 a0 = *(LAS const bf16x8*)(lds + ATT_OFF + r32 * KTP + (16 * ks + 8 * hi) * 2); o0 = __builtin_amdgcn_mfma_f32_32x32x16_bf16(a0, vf[ks], o0, 0, 0, 0); } }
#pragma unroll
        for (int kb = 0; kb < 4; ++kb)
#pragma unroll
            for (int s2 = 0; s2 < 2; ++s2) {
                att::u32x4v sw; sw.x = att::cvtpk(S[kb][8 * s2 + 0], S[kb][8 * s2 + 1]); sw.y = att::cvtpk(S[kb][8 * s2 + 2], S[kb][8 * s2 + 3]);
                sw.z = att::cvtpk(S[kb][8 * s2 + 4], S[kb][8 * s2 + 5]); sw.w = att::cvtpk(S[kb][8 * s2 + 6], S[kb][8 * s2 + 7]);
                const bf16x8 sb = __builtin_bit_cast(bf16x8, sw);
                const int col = 32 * kb + 16 * s2 + 4 * hi;
                const v2u qa0 = *(LAS const v2u*)(lds + QE_OFF + r32 * QP + col * 2), qa1 = *(LAS const v2u*)(lds + QE_OFF + r32 * QP + (col + 8) * 2);
                const v2u qb0 = *(LAS const v2u*)(lds + QE_OFF + (32 + r32) * QP + col * 2), qb1 = *(LAS const v2u*)(lds + QE_OFF + (32 + r32) * QP + (col + 8) * 2);
                const att::u32x4v A0 = {qa0.x, qa0.y, qa1.x, qa1.y}, A1 = {qb0.x, qb0.y, qb1.x, qb1.y};
                o0 = __builtin_amdgcn_mfma_f32_32x32x16_bf16(__builtin_bit_cast(bf16x8, A0), sb, o0, 0, 0, 0);
                o1 = __builtin_amdgcn_mfma_f32_32x32x16_bf16(__builtin_bit_cast(bf16x8, A1), sb, o1, 0, 0, 0); }
#pragma unroll
        for (int kb = 0; kb < 4; ++kb) {
#pragma unroll
            for (int q4 = 0; q4 < 4; ++q4) { const f32x4 dc = *(LAS const f32x4*)(DEC + 32 * kb + 8 * q4 + 4 * hi);
#pragma unroll
                for (int e = 0; e < 4; ++e) S[kb][4 * q4 + e] *= dc[e]; }
#pragma unroll
            for (int ks = 0; ks < 4; ++ks) { const bf16x8 a = *(LAS const bf16x8*)(lds + KDT_OFF + (32 * kb + r32) * KTP + (16 * ks + 8 * hi) * 2);
                S[kb] = __builtin_amdgcn_mfma_f32_32x32x16_bf16(a, vf[ks], S[kb], 0, 0, 0); } }
        GLA_BAR();
        GLA_PROF(3);
        GLA_DMA(V_OFF, U_VB, tokn);
#pragma unroll
        for (int r = 0; r < 16; ++r) { const int c = att::crow(r, hi);
            *(LAS float*)(lds + O_OFF + c * OP + (32 * wid + r32) * 4) = o0[r]; *(LAS float*)(lds + O_OFF + (32 + c) * OP + (32 * wid + r32) * 4) = o1[r]; }
        GLA_BAR();
        { const int c = tid >> 3, seg = tid & 7; f32x4 ov[8]; float ss = 0.f;
#pragma unroll
          for (int k = 0; k < 8; ++k) { ov[k] = *(LAS const f32x4*)(lds + O_OFF + c * OP + (32 * seg + 4 * k) * 4); ss += (ov[k].x * ov[k].x + ov[k].y * ov[k].y) + (ov[k].z * ov[k].z + ov[k].w * ov[k].w); }
          ss += __shfl_xor(ss, 1); ss += __shfl_xor(ss, 2); ss += __shfl_xor(ss, 4);
          const float rs = __builtin_amdgcn_rsqf(ss * (1.0f / 256.0f) + EPS);
          LAS const unsigned char* gp = lds + G_OFF + c * 512 + 32 * seg * 2; bf16* op = OB + (size_t)(tok0 + c) * DM + 1024 + h * 256 + 32 * seg;
#pragma unroll
          for (int k2 = 0; k2 < 4; ++k2) { const v4u gw = *(LAS const v4u*)(gp + 16 * k2); const f32x4 n0 = *(LAS const f32x4*)(GN + 32 * seg + 8 * k2), n1 = *(LAS const f32x4*)(GN + 32 * seg + 8 * k2 + 4);
              float gv[8] = {bflo(gw.x), bfhi(gw.x), bflo(gw.y), bfhi(gw.y), bflo(gw.z), bfhi(gw.z), bflo(gw.w), bfhi(gw.w)};
              float xv[8] = {ov[2 * k2].x * n0.x, ov[2 * k2].y * n0.y, ov[2 * k2].z * n0.z, ov[2 * k2].w * n0.w, ov[2 * k2 + 1].x * n1.x, ov[2 * k2 + 1].y * n1.y, ov[2 * k2 + 1].z * n1.z, ov[2 * k2 + 1].w * n1.w};
              float rv[8];
#pragma unroll
              for (int e = 0; e < 8; ++e) rv[e] = xv[e] * rs * gv[e];
              v4u w; w.x = pk2(rv[0], rv[1]); w.y = pk2(rv[2], rv[3]); w.z = pk2(rv[4], rv[5]); w.w = pk2(rv[6], rv[7]); *(v4u*)(op + 8 * k2) = w; } }
        GLA_BAR();
        GLA_PROF(4);
        GLA_DMA(G_OFF, U_GB, tokn);
    }
    asm volatile("s_waitcnt vmcnt(0)" ::: "memory"); GLA_BAR();
#undef GLA_DMA
#undef GLA_PROF
}
}
#ifndef MK_ONE_LAUNCH
#define MK_ONE_LAUNCH 1
#endif
#ifndef MK_NAIVE_DSA
#define MK_NAIVE_DSA 0
#endif
#ifndef MK_DSA_MODE
#define MK_DSA_MODE 0
#endif
#ifndef MK_NAIVE_GLA
#define MK_NAIVE_GLA 0
#endif
#ifndef MK_NAIVE_SB
#define MK_NAIVE_SB 0
#endif
#ifndef MK_STAGGER_F8_TICKS
#define MK_STAGGER_F8_TICKS 0
#endif
#ifndef MK_STAGGER_TICKS
#define MK_STAGGER_TICKS 0
#define MK_STAGGER_CLS 4
#endif
#ifndef MK_GEMM_ALIGN
#define MK_GEMM_ALIGN true
#endif
#ifndef MK_GEMM_SP2
#define MK_GEMM_SP2 true
#endif
#ifndef MK_REP_MASK
#define MK_REP_MASK 0
#endif
#ifndef MK_SPIN_MULT
#define MK_SPIN_MULT 0
#define MK_SPIN_A 0
#define MK_SPIN_B 0
#endif
#ifndef MK_SPIN_BLOCK
#define MK_SPIN_BLOCK 0
#endif
constexpr int N_PHASES = 20;
struct Args { const float* in[19]; float* out; unsigned char* ws; int ph_lo, ph_hi; };
static_assert(sizeof(Args) == 19 * 8 + 8 + 8 + 8, "Args has no padding");

__global__ void __launch_bounds__(NWAVES * 64, 2) mk_fwd(Args args) {
    extern __shared__ __attribute__((aligned(16))) unsigned char lds[];
    Frame F;
    F.lds = (LAS unsigned char*)lds;
    F.MISC = (volatile LAS unsigned*)(F.lds + MISC_OFF);
    F.tid = threadIdx.x; F.lane = F.tid & 63; F.wave = __builtin_amdgcn_readfirstlane(F.tid >> 6);
    F.G = gridDim.x; { const int bx = blockIdx.x; F.vcu = (F.G % 8 == 0) ? (bx % 8) * (F.G / 8) + bx / 8 : bx; }
    unsigned char* ws = args.ws; F.ws = ws; F.out = args.out;
    F.ctl = (gu32*)(ws + WS_CTL);
#pragma unroll
    for (int i = 0; i < 19; ++i) F.in[i] = args.in[i];
    for (int u = F.tid; u < (LDS_BYTES - LDSCTL_OFF) / 4; u += NWAVES * 64) ((LAS unsigned*)(F.lds + LDSCTL_OFF))[u] = 0u;
    __syncthreads();
    XcdBarrier bar; bar.bar = (unsigned*)(F.ctl + CW_BAR); bar.x = 0; bar.st = nullptr;
    if (MK_ONE_LAUNCH) bar = xcd_barrier_post((unsigned*)(F.ctl + CW_BAR), F.MISC + 8);
#define GRID_BAR() do { if (MK_ONE_LAUNCH) xcd_barrier(bar); } while (0)
#define STAMP(i) do { if ((MK_SPIN_MULT || MK_CLK_PROBE) && bx0 == MK_SPIN_BLOCK && F.tid == 0) { \
        if ((i) == MK_SPIN_A) { const unsigned long long t_ = __builtin_amdgcn_s_memrealtime(); F.MISC[2] = (unsigned)t_; F.MISC[3] = (unsigned)(t_ >> 32); F.MISC[6] = (unsigned)__builtin_amdgcn_s_memtime(); } \
        if ((i) == MK_SPIN_B) { const unsigned long long t_ = __builtin_amdgcn_s_memrealtime(); F.MISC[4] = (unsigned)t_; F.MISC[5] = (unsigned)(t_ >> 32); F.MISC[7] = (unsigned)__builtin_amdgcn_s_memtime(); } \
        if (MK_GEMM_PROF && (i) == MK_SPIN_A) { F.MISC[20] = 0u; F.MISC[21] = 0u; F.MISC[22] = 0u; }     \
        if (MK_GEMM_PROF && (i) == MK_SPIN_B) { F.MISC[28] = F.MISC[20]; F.MISC[29] = F.MISC[21]; F.MISC[30] = F.MISC[22]; } } } while (0)
    const int bx0 = (int)blockIdx.x;
    STAMP(0);
    const int lo = args.ph_lo, hi = args.ph_hi;
#define IN(k) (lo <= (k) && (k) < hi)
#define BOTH(k) (IN(k) && (k) + 1 < hi)
    bf16* HB = (bf16*)(ws + WS_HB); float* SQA = (float*)(ws + WS_SSQA); float* SQB = (float*)(ws + WS_SSQB); bf16* BIG = (bf16*)(ws + WS_BIG); bf16* OB = (bf16*)(ws + WS_OB); bf16* PB = (bf16*)(ws + WS_PB);
    const int bx = (int)blockIdx.x;

#define GEMM_CALL(EPI, A_, BT_, N_, K_, ...) GEMM_CALLX(false, EPI, A_, BT_, N_, K_, __VA_ARGS__)
#define GEMM_CALLX(F8_, EPI, A_, BT_, N_, K_, ...) do { pg8::Gemm g{A_, (const bf16*)(BT_), MT, N_, K_}; pg8::StaticOrder S; S.init(MT, N_, F.G, bx); int rtag = -1; (void)rtag; \
        const pg8::RstdCache RC{&rtag, (LAS float*)(F.lds + 131072) + F.wave * 512}; (void)RC; pg8::EPI E{__VA_ARGS__}; \
        if (MK_STAGGER_F8_TICKS && (F8_)) { const unsigned long long t0_ = __builtin_amdgcn_s_memrealtime(), w_ = (unsigned long long)(((unsigned)F.vcu >> 5) & 1u) * MK_STAGGER_F8_TICKS;   \
            while (__builtin_amdgcn_s_memrealtime() - t0_ < w_) __builtin_amdgcn_s_sleep(4); } \
        if (MK_STAGGER_TICKS && (N_) > 2048) { const unsigned long long t0_ = __builtin_amdgcn_s_memrealtime(), w_ = (unsigned long long)(((unsigned)F.vcu >> 5) & (MK_STAGGER_CLS - 1)) * MK_STAGGER_TICKS;   \
            while (__builtin_amdgcn_s_memrealtime() - t0_ < w_) __builtin_amdgcn_s_sleep(4); } \
        pg8::gemm_phase<pg8::EPI, pg8::StaticOrder, MK_GEMM_ALIGN, MK_GEMM_SP2, F8_>(F.lds + RING_OFF, g, S, E); } while (0)
#define BODY_0()  do { p0_prologue<1>(F); p0_prologue<0>(F); } while (0)
#define BODY_1()  GEMM_CALL(EpiScaleBf16, HB, ws + WS_WIN0, LDU, DM, BIG, LDU, SQA, RC, U_GB, U_LR)
#if !MK_NAIVE_GLA
#define BODY_2A() do { if (bx < 64) gla::gla_unit(F.lds, BIG, F.in[4], F.in[5], F.in[6], OB, bx >> 2, bx & 3); } while (0)
#else
#define BODY_2A() do { } while (0)
#endif
#if !MK_NAIVE_DSA && (MK_DSA_MODE == 0 || MK_DSA_MODE == 3)
#define BODY_2B(QW) do { __syncthreads(); if (F.tid == 0) F.MISC[0] = __hip_atomic_fetch_add((unsigned*)(F.ctl + (QW)), 1u, __ATOMIC_RELAXED, __HIP_MEMORY_SCOPE_AGENT); __syncthreads(); \
        int q = (int)F.MISC[0]; unsigned qn = 0u; gu32* flg = F.ctl + (QW) + CW_FLG_REL; \
          \
          \
        while (q < 3072) {                                                \
            if (F.tid == 0) qn = __hip_atomic_fetch_add((unsigned*)(F.ctl + (QW)), 1u, __ATOMIC_RELAXED, __HIP_MEMORY_SCOPE_AGENT); \
            if (q < 2048) { const int c = 31 - (q >> 6), rem = q & 63, b_ = rem >> 2, g_ = 4 * c + (rem & 3); \
                idx::topk_unit(F.lds, BIG, (unsigned*)(ws + WS_MASK), b_, g_);     \
                asm volatile("s_waitcnt vmcnt(0)" ::: "memory"); __syncthreads(); \
                if (F.tid == 0) { __hip_atomic_store((unsigned*)(flg + b_ * 128 + g_), 1u, __ATOMIC_RELAXED, __HIP_MEMORY_SCOPE_AGENT); F.MISC[0] = qn; } } \
            else { const int qa = q - 2048, qb_ = 63 - (qa >> 4), b_ = qa & 15; \
                if (F.tid == 0) { unsigned sp_ = 0u; \
                    while (__hip_atomic_load((unsigned*)(flg + b_ * 128 + 2 * qb_), __ATOMIC_RELAXED, __HIP_MEMORY_SCOPE_AGENT) == 0u || __hip_atomic_load((unsigned*)(flg + b_ * 128 + 2 * qb_ + 1), __ATOMIC_RELAXED, __HIP_MEMORY_SCOPE_AGENT) == 0u) { \
                        __builtin_amdgcn_s_sleep(2); if (++sp_ > (1u << 22)) break; }     \
                    __builtin_amdgcn_fence(__ATOMIC_ACQUIRE, "agent"); asm volatile("s_waitcnt vmcnt(0)" ::: "memory"); } \
                __syncthreads(); \
                att::dsa_attn_unit(F.lds, BIG, (const unsigned long long*)(ws + WS_MASK), OB, b_, qb_); \
                if (F.tid == 0) F.MISC[0] = qn; } \
            __syncthreads(); q = (int)F.MISC[0]; } } while (0)
#else
#define BODY_2B(QW) do { } while (0)
#endif
#define BODY_2()  do { BODY_2A(); STAMP(30); BODY_2B(CW_Q); STAMP(31); } while (0)
#if !MK_NAIVE_DSA && (MK_DSA_MODE == 0 || MK_DSA_MODE == 2)
#define BODY_3()  att::dsa_attn_phase(F)
#else
#define BODY_3()  do { } while (0)
#endif
#define BODY_4()  GEMM_CALL(EpiRes, OB, ws + WS_WOUT0, DM, DM, HB, HB, DM, SQA, nullptr)
#define BODY_11() GEMM_CALL(EpiScaleBf16, HB, ws + WS_WIN1, LDQKV, DM, BIG, LDQKV, SQB, RC, 0, -2048)
#if !MK_NAIVE_SB
#define BODY_12() att::sb_phase(F)
#else
#define BODY_12() do { } while (0)
#endif
#define BODY_13() GEMM_CALL(EpiRes, OB, ws + WS_WOUT1, DM, DM, HB, HB, DM, SQA, nullptr)
#define BODY_NORM() norm_phase(F, F.out)
#define BODY_UP(l)   GEMM_CALL(EpiSwiglu, HB, ws + WS_WGU + (size_t)(l) * 44 * MiB, 2 * FF, DM, BIG, FF, SQA, RC)
#define BODY_DOWN(l) GEMM_CALL(EpiRes, BIG, ws + WS_WD + (size_t)(l) * 22 * MiB, DM, FF, HB, HB, DM, SQA, ws + WS_H8)
#define BODY_PE(l)   GEMM_CALL(EpiScaleBf16, PB + (size_t)(l) * MT * PLE, ws + WS_WPE + (size_t)(l) * 1 * MiB, DM, PLE, ((l) ? HB : OB), DM, nullptr, RC, 0, 0)
#define BODY_PLE(l)  do { GEMM_CALLX(true, EpiGate8, (const bf16*)(ws + WS_H8), ws + WS_WPG + (size_t)(l) * 8 * MiB, DM, DM / 2, ws + WS_OB, DM, SQA, 0.015625f);     \
        STAMP((l) ? 99 : 9); \
        GEMM_CALL(EpiPeComb, PB + (size_t)(l) * MT * PLE, ws + WS_WPE + (size_t)(l) * 1 * MiB, DM, PLE, HB, ws + WS_OB, DM, SQB); } while (0)
#define REP(k) ((MK_REP_MASK >> (k)) & 1)
#define PHASE(k, BODY) do { if (IN(k)) { BODY; if (REP(k)) { GRID_BAR(); BODY; } if (BOTH(k)) GRID_BAR(); STAMP((k) + 1); } } while (0)

    PHASE(0, BODY_0());
    PHASE(1, BODY_1());
    if (IN(2)) { BODY_2(); if (REP(2)) { GRID_BAR(); BODY_2A(); BODY_2B(CW_Q + 4096); } if (BOTH(2)) GRID_BAR(); STAMP(3); }
    if (IN(4)) { BODY_4(); if (BOTH(4)) GRID_BAR(); STAMP(5); }
#ifndef MK_IDLE_TICKS
#define MK_IDLE_TICKS 0
#endif
    if (MK_IDLE_TICKS) { const unsigned long long t0_ = __builtin_amdgcn_s_memrealtime(); while (__builtin_amdgcn_s_memrealtime() - t0_ < (unsigned long long)MK_IDLE_TICKS) __builtin_amdgcn_s_sleep(32); }
    PHASE(6, BODY_UP(0));
    if (IN(7)) { BODY_DOWN(0); if (BOTH(7)) GRID_BAR(); STAMP(8); }
    if (IN(9)) { BODY_PLE(0); if (BOTH(9)) GRID_BAR(); STAMP(10); }
    PHASE(11, BODY_11());
    PHASE(12, BODY_12());
    if (IN(13)) { BODY_13(); if (BOTH(13)) GRID_BAR(); STAMP(14); }
    PHASE(15, BODY_UP(1));
    if (IN(16)) { BODY_DOWN(1); if (BOTH(16)) GRID_BAR(); STAMP(17); }
    if (IN(18)) { BODY_PLE(1); if (BOTH(18)) GRID_BAR(); STAMP(19); }
    if (IN(19)) { final_norm_phase(F); STAMP(20); }
    const unsigned long long st_a = (MK_SPIN_MULT || MK_CLK_PROBE) ? ((unsigned long long)F.MISC[3] << 32 | F.MISC[2]) : 0ull, st_b = (MK_SPIN_MULT || MK_CLK_PROBE) ? ((unsigned long long)F.MISC[5] << 32 | F.MISC[4]) : 0ull; const unsigned long long ck_a = 0ull, ck_b = (unsigned)(F.MISC[7] - F.MISC[6]);
    (void)ck_a; (void)ck_b; (void)st_a; (void)st_b;
#if MK_CLK_PROBE
    if (bx0 == MK_SPIN_BLOCK && F.tid == 0) { const unsigned long long dc = ck_b - ck_a, dr = st_b - st_a;
        const unsigned long long w = dc * 10000ull / dr, t0 = __builtin_amdgcn_s_memrealtime(); while (__builtin_amdgcn_s_memrealtime() - t0 < w) __builtin_amdgcn_s_sleep(8); }
#endif
    if (MK_SPIN_MULT && bx0 == MK_SPIN_BLOCK && F.tid == 0) { const unsigned long long t0 = __builtin_amdgcn_s_memrealtime(), w = ((MK_SB_PROF || MK_GEMM_PROF || MK_IDX_PROF || MK_GLA_PROF) ? (unsigned long long)F.MISC[(MK_GEMM_PROF ? 24 : 16) + MK_SB_SEL] : (st_b - st_a)) * (unsigned long long)MK_SPIN_MULT; while (__builtin_amdgcn_s_memrealtime() - t0 < w) __builtin_amdgcn_s_sleep(8); }
#undef IN
#undef BOTH
}

extern "C" void kernel_launch(void* const* d_in, const int* in_sizes, int n_in, void* d_out, int out_size, void* d_ws, size_t ws_size, hipStream_t stream) {
    static int grid = 0;
    if (grid == 0) {
        if (n_in != 19 || in_sizes[0] != MT * DM || out_size != MT * DM || ws_size < WS_END) { fprintf(stderr, "kernel_launch: shape/workspace mismatch (n_in %d, ws %zu < %zu)\n", n_in, ws_size, (size_t)WS_END); grid = -1; return; }
        int dev = 0, cus = 0;
        if (hipGetDevice(&dev) != hipSuccess || hipDeviceGetAttribute(&cus, hipDeviceAttributeMultiprocessorCount, dev) != hipSuccess) { grid = -1; return; }
        if (hipFuncSetAttribute((const void*)mk_fwd, hipFuncAttributeMaxDynamicSharedMemorySize, LDS_BYTES) != hipSuccess) { fprintf(stderr, "kernel_launch: hipFuncSetAttribute failed\n"); grid = -1; return; }
        int per_cu = 0;
        if (hipOccupancyMaxActiveBlocksPerMultiprocessor(&per_cu, (const void*)mk_fwd, NWAVES * 64, LDS_BYTES) != hipSuccess || per_cu < 1) { fprintf(stderr, "kernel_launch: occupancy query says %d\n", per_cu); }
        (void)hipGetLastError();
        grid = cus;
    }
    if (grid < 0) return;
    hipMemsetAsync((char*)d_ws + WS_CTL, 0, CTL_ZERO_BYTES, stream);
    Args a{};
    for (int i = 0; i < 19; ++i) a.in[i] = (const float*)d_in[i];
    a.out = (float*)d_out; a.ws = (unsigned char*)d_ws;
    unsigned char* ws = (unsigned char*)d_ws;
#if MK_ONE_LAUNCH
    a.ph_lo = 0; a.ph_hi = N_PHASES;
    hipLaunchKernelGGL(mk_fwd, dim3(grid), dim3(NWAVES * 64), LDS_BYTES, stream, a);
#else
    for (int p = 0; p < N_PHASES; ++p) { a.ph_lo = p; a.ph_hi = p + 1; hipLaunchKernelGGL(mk_fwd, dim3(grid), dim3(NWAVES * 64), LDS_BYTES, stream, a); }
#endif
    const hipError_t le = hipPeekAtLastError();
    if (le != hipSuccess) fprintf(stderr, "kernel_launch: launch failed: %s\n", hipGetErrorName(le));
}
```
